# Optimizing an MI355X kernel written in HIP

```python
import math
import jax, jax.numpy as jnp
from jax import lax
import numpy as np

D_MODEL = 1024
BATCH = 8
SEQ = 4096
DEPTH = 4

N_MIXERS = 2
N_LAYERS_A = (DEPTH + 1) // 2
N_LAYERS_B = DEPTH // 2
D_FF = 2752
FFN_HALF = 0.5
ROPE_THETA = 500000.0
ROT_FRAC = 4
Q_BLOCK = 128
EPS = 1e-6
N_MOD = 9

A_HEADS = 16
A_HEAD_DIM = 64
A_KV_DIM = 64
IDX_HEADS = 8
IDX_DIM = 64
TOPK_MAX = 256
A_Q = A_HEADS * A_HEAD_DIM
A_IN = A_Q + 2 * A_KV_DIM + IDX_HEADS * IDX_DIM + IDX_DIM + IDX_HEADS

B_HEADS = 8
B_HEAD_DIM = 64
B_V_DIM = 2 * B_HEAD_DIM
B_QK = 2 * B_HEADS * B_HEAD_DIM
B_IN = 2 * B_QK + B_HEADS * B_V_DIM

kernel_name = "hybrid_dsa_diffattn_macaron_adaln"


def rmsnorm(x, g):
    xf = x.astype(jnp.float32)
    y = xf * lax.rsqrt(jnp.mean(xf * xf, axis=-1, keepdims=True) + EPS)
    return (y * g.astype(jnp.float32)).astype(x.dtype)


def modulate(h, shift, scale):
    return h * (1.0 + scale[:, None, :]) + shift[:, None, :]


def swiglu(h, w_gate, w_up, w_down):
    return (jax.nn.silu(h @ w_gate) * (h @ w_up)) @ w_down


def rope_tables(positions, head_dim):
    rot = head_dim // ROT_FRAC
    inv = ROPE_THETA ** (-jnp.arange(0, rot, 2, dtype=jnp.float32) / rot)
    ang = positions.astype(jnp.float32)[..., None] * inv
    return jnp.cos(ang), jnp.sin(ang)


def apply_rope(x, cos, sin):
    half = cos.shape[-1]
    rot = 2 * half
    shp = cos.shape[:2] + (1,) * (x.ndim - 3) + (half,)
    cos = cos.reshape(shp)
    sin = sin.reshape(shp)
    x1 = x[..., :half].astype(jnp.float32)
    x2 = x[..., half:rot].astype(jnp.float32)
    xr = jnp.concatenate([x1 * cos - x2 * sin, x2 * cos + x1 * sin], axis=-1)
    return jnp.concatenate([xr.astype(x.dtype), x[..., rot:]], axis=-1)


def dsa_mixer(h, w_in, w_out, cos, sin):
    B, S, _ = h.shape
    top_k = min(TOPK_MAX, S // 4)
    proj = h @ w_in
    o1 = A_Q
    o2 = o1 + A_KV_DIM
    o3 = o2 + A_KV_DIM
    o4 = o3 + IDX_HEADS * IDX_DIM
    o5 = o4 + IDX_DIM
    q = apply_rope(proj[..., :o1].reshape(B, S, A_HEADS, A_HEAD_DIM), cos, sin)
    k = apply_rope(proj[..., o1:o2], cos, sin)
    v = proj[..., o2:o3]
    qi = apply_rope(proj[..., o3:o4].reshape(B, S, IDX_HEADS, IDX_DIM), cos, sin)
    ki = apply_rope(proj[..., o4:o5], cos, sin)
    wi = proj[..., o5:].astype(jnp.float32) * (IDX_HEADS ** -0.5 * IDX_DIM ** -0.5)
    ki32 = ki.astype(jnp.float32)
    key_pos = jnp.arange(S)
    scale = A_HEAD_DIM ** -0.5
    gather = jax.vmap(lambda arr, ids: arr[ids])

    def block(i):
        start = i * Q_BLOCK
        t = start + jnp.arange(Q_BLOCK)
        q_b = lax.dynamic_slice_in_dim(q, start, Q_BLOCK, axis=1)
        qi_b = lax.dynamic_slice_in_dim(qi, start, Q_BLOCK, axis=1)
        wi_b = lax.dynamic_slice_in_dim(wi, start, Q_BLOCK, axis=1)
        logits = jnp.einsum('bthd,bsd->bths', qi_b.astype(jnp.float32), ki32)
        score = jnp.einsum('bth,bths->bts', wi_b, jax.nn.relu(logits))
        causal = key_pos[None, :] <= t[:, None]
        score = jnp.where(causal[None], score, -jnp.inf)
        _, idx = lax.top_k(score, top_k)
        k_sel = gather(k, idx).astype(jnp.float32)
        v_sel = gather(v, idx).astype(jnp.float32)
        s = jnp.einsum('bthd,btkd->bhtk', q_b.astype(jnp.float32), k_sel) * scale
        valid = idx <= t[None, :, None]
        s = jnp.where(valid[:, None], s, -jnp.inf)
        p = jax.nn.softmax(s, axis=-1)
        o = jnp.einsum('bhtk,btkd->bthd', p, v_sel)
        return o.reshape(B, Q_BLOCK, A_HEADS * A_KV_DIM).astype(h.dtype)

    out = lax.map(block, jnp.arange(S // Q_BLOCK))
    out = jnp.transpose(out, (1, 0, 2, 3)).reshape(B, S, A_HEADS * A_KV_DIM)
    return out @ w_out


def diff_mixer(h, w_in, w_out, lam, subln_g, cos, sin, layer_idx):
    B, S, _ = h.shape
    lam_init = 0.8 - 0.6 * math.exp(-0.3 * layer_idx)
    proj = h @ w_in
    q = apply_rope(proj[..., :B_QK].reshape(B, S, 2, B_HEADS, B_HEAD_DIM), cos, sin)
    k = apply_rope(proj[..., B_QK:2 * B_QK].reshape(B, S, 2, B_HEADS, B_HEAD_DIM), cos, sin)
    v = proj[..., 2 * B_QK:].reshape(B, S, B_HEADS, B_V_DIM)
    lam32 = lam.astype(jnp.float32)
    lam_val = (jnp.exp(jnp.sum(lam32[0] * lam32[1])) - jnp.exp(jnp.sum(lam32[2] * lam32[3]))
               + lam_init)
    k32 = k.astype(jnp.float32)
    v32 = v.astype(jnp.float32)
    key_pos = jnp.arange(S)
    scale = B_HEAD_DIM ** -0.5

    def block(i):
        start = i * Q_BLOCK
        t = start + jnp.arange(Q_BLOCK)
        q_b = lax.dynamic_slice_in_dim(q, start, Q_BLOCK, axis=1).astype(jnp.float32)
        s = jnp.einsum('btchd,bschd->bchts', q_b, k32) * scale
        causal = key_pos[None, :] <= t[:, None]
        s = jnp.where(causal, s, -jnp.inf)
        p = jax.nn.softmax(s, axis=-1)
        a = p[:, 0] - lam_val * p[:, 1]
        o = jnp.einsum('bhts,bshe->bthe', a, v32)
        o = rmsnorm(o, subln_g) * (1.0 - lam_init)
        return o.reshape(B, Q_BLOCK, B_HEADS * B_V_DIM).astype(h.dtype)

    out = lax.map(block, jnp.arange(S // Q_BLOCK))
    out = jnp.transpose(out, (1, 0, 2, 3)).reshape(B, S, B_HEADS * B_V_DIM)
    return out @ w_out


def setup_inputs(seed: int = 0) -> dict:
    key = jax.random.key(seed)
    ks = jax.random.split(key, 18)
    f32 = jnp.float32

    def nrm(k, shape, fan_in, scale=1.0):
        return jax.random.normal(k, shape, f32) * (scale * fan_in ** -0.5)

    x = jax.random.normal(ks[0], (BATCH, SEQ, D_MODEL), f32)
    c = jax.random.normal(ks[1], (BATCH, D_MODEL), f32)
    offsets = jax.random.randint(ks[2], (BATCH, 1), 0, 1024, dtype=jnp.int32)
    positions = offsets + jnp.arange(SEQ, dtype=jnp.int32)[None, :]
    return {
        "x": x,
        "c": c,
        "positions": positions,
        "ada_w": nrm(ks[3], (DEPTH, D_MODEL, N_MOD * D_MODEL), D_MODEL, 0.5),
        "ada_b": 0.02 * jax.random.normal(ks[4], (DEPTH, N_MOD * D_MODEL), f32),
        "pre_norm": 1.0 + 0.05 * jax.random.normal(ks[5], (DEPTH, 3, D_MODEL), f32),
        "post_norm": 1.0 + 0.05 * jax.random.normal(ks[6], (DEPTH, 3, D_MODEL), f32),
        "ffn_w_gate": nrm(ks[7], (DEPTH, 2, D_MODEL, D_FF), D_MODEL),
        "ffn_w_up": nrm(ks[8], (DEPTH, 2, D_MODEL, D_FF), D_MODEL),
        "ffn_w_down": nrm(ks[9], (DEPTH, 2, D_FF, D_MODEL), D_FF),
        "dsa_w_in": nrm(ks[10], (N_LAYERS_A, D_MODEL, A_IN), D_MODEL),
        "dsa_w_out": nrm(ks[11], (N_LAYERS_A, A_HEADS * A_KV_DIM, D_MODEL), A_HEADS * A_KV_DIM),
        "diff_w_in": nrm(ks[12], (N_LAYERS_B, D_MODEL, B_IN), D_MODEL),
        "diff_w_out": nrm(ks[13], (N_LAYERS_B, B_HEADS * B_V_DIM, D_MODEL), B_HEADS * B_V_DIM),
        "diff_lambda": 0.1 * jax.random.normal(ks[14], (N_LAYERS_B, 4, B_HEAD_DIM), f32),
        "diff_subln": 1.0 + 0.05 * jax.random.normal(ks[15], (N_LAYERS_B, B_V_DIM), f32),
    }


def reference(x, c, positions, ada_w, ada_b, pre_norm, post_norm, ffn_w_gate, ffn_w_up,
              ffn_w_down, dsa_w_in, dsa_w_out, diff_w_in, diff_w_out, diff_lambda, diff_subln):
    cos, sin = rope_tables(positions, A_HEAD_DIM)
    cond = jax.nn.silu(c)
    for i in range(DEPTH):
        mod = cond @ ada_w[i] + ada_b[i]
        sh0, sc0, g0, sh1, sc1, g1, sh2, sc2, g2 = jnp.split(mod, N_MOD, axis=-1)
        h = modulate(rmsnorm(x, pre_norm[i, 0]), sh0, sc0)
        y = swiglu(h, ffn_w_gate[i, 0], ffn_w_up[i, 0], ffn_w_down[i, 0])
        x = x + FFN_HALF * g0[:, None, :] * rmsnorm(y, post_norm[i, 0])
        h = modulate(rmsnorm(x, pre_norm[i, 1]), sh1, sc1)
        j = i // N_MIXERS
        if i % N_MIXERS == 0:
            y = dsa_mixer(h, dsa_w_in[j], dsa_w_out[j], cos, sin)
        else:
            y = diff_mixer(h, diff_w_in[j], diff_w_out[j], diff_lambda[j], diff_subln[j],
                           cos, sin, i)
        x = x + g1[:, None, :] * rmsnorm(y, post_norm[i, 1])
        h = modulate(rmsnorm(x, pre_norm[i, 2]), sh2, sc2)
        y = swiglu(h, ffn_w_gate[i, 1], ffn_w_up[i, 1], ffn_w_down[i, 1])
        x = x + FFN_HALF * g2[:, None, :] * rmsnorm(y, post_norm[i, 2])
    return x
```

```cpp
#include <hip/hip_runtime.h>
#include <hip/hip_bf16.h>
#include <cstdio>
#include <cstdint>
#include <cmath>
namespace pg8 {
#define PG8_LAS __attribute__((address_space(3)))
typedef unsigned short bf16_t;
typedef short bf16x8 __attribute__((ext_vector_type(8)));
typedef float f32x4 __attribute__((ext_vector_type(4)));
typedef unsigned u32x4 __attribute__((ext_vector_type(4)));
constexpr int BM = 256, BK = 64, HALF = 128, HTB = HALF * BK * 2  , STAGE_BYTES = 8 * HTB, NXCD = 8, WGM = 8;

__host__ __device__ __forceinline__ int lds_byte(int r, int c) { const int st = (r >> 4) * 2 + (c >> 5), rr = r & 15, cc = c & 31, ob = rr * 64 + cc * 2; return st * 1024 + (ob ^ (((ob >> 9) & 1) << 5)); }
__host__ __device__ __forceinline__ void stage_rc(int b, int& R, int& C) { const int st = b / 1024, sb = b % 1024, swz = sb ^ (((sb >> 9) & 1) << 5); R = (st >> 1) * 16 + swz / 64; C = (st & 1) * 32 + (swz % 64) / 2; }
__host__ __device__ __forceinline__ int perm32(int rho) { const int n = rho >> 4, i = rho & 15; return 8 * (i >> 2) + 4 * n + (i & 3); }

struct Unit { int pm, pn; };
struct Gemm { const bf16_t* A; const bf16_t* Bt; int M, N, K; };

struct StaticOrder {
    int nM, nN, nwg, G, c;
    __host__ __device__ void init(int M, int N, int G_, int c_) { nM = M / BM; nN = N / BM; nwg = nM * nN; G = G_; c = c_; }
    __host__ __device__ bool next(int i, Unit& u) const {
        const long L = (long)i * G + c; if (L >= nwg) return false;
        int wgid = (int)L; { const int q = nwg / NXCD, r = nwg % NXCD, xcd = wgid % NXCD, off = wgid / NXCD; wgid = (xcd < r ? xcd * (q + 1) : r * (q + 1) + (xcd - r) * q) + off; }
        const int nig = WGM * nN, gid = wgid / nig, fm = gid * WGM, gsz = (nM - fm) < WGM ? (nM - fm) : WGM;
        u.pm = fm + ((wgid % nig) % gsz); u.pn = (wgid % nig) / gsz; return true;
    }
    __device__ __forceinline__ void a_ready(const Unit&) const {}
    __device__ __forceinline__ void done(const Unit&) const {}
};

__device__ __forceinline__ unsigned cvt_pk_bf16(float lo, float hi) { unsigned r; asm volatile("v_cvt_pk_bf16_f32 %0, %1, %2" : "=v"(r) : "v"(lo), "v"(hi)); return r; }
typedef float f32x2 __attribute__((ext_vector_type(2)));
template <int ACT> struct EpiBf16 {
    static constexpr bool PERM = true, AFTER_DRAIN = false;
    bf16_t* O; int ldc;
    __device__ __forceinline__ void operator()(const f32x4 (&acc)[2][2][4][2], const Unit& u, int wr, int wc, int fr, int fq) const {
        const int row0 = u.pm * BM + wr * 64 + fr; const int col0 = u.pn * BM + wc * 32 + 8 * fq;
#pragma unroll
        for (int ai = 0; ai < 2; ++ai)
#pragma unroll
            for (int m = 0; m < 4; ++m) { bf16_t* rowp = O + (size_t)(row0 + ai * HALF + m * 16) * ldc + col0;
#pragma unroll
                for (int bj = 0; bj < 2; ++bj) { const f32x4 v0 = acc[ai][bj][m][0], v1 = acc[ai][bj][m][1];
                    u32x4 w; w.x = cvt_pk_bf16(v0[0], v0[1]); w.y = cvt_pk_bf16(v0[2], v0[3]); w.z = cvt_pk_bf16(v1[0], v1[1]); w.w = cvt_pk_bf16(v1[2], v1[3]);
                    *(u32x4*)(rowp + bj * HALF) = w; } }
    }
};

struct EpiSwiGLU {
    static constexpr bool PERM = true, AFTER_DRAIN = false;
    bf16_t* O; int ldc;
    __device__ __forceinline__ static float sg(float g, float u) { const float e = __builtin_amdgcn_exp2f(g * -1.4426950408889634f); return g * u * __builtin_amdgcn_rcpf(1.0f + e); }
    __device__ __forceinline__ void operator()(const f32x4 (&acc)[2][2][4][2], const Unit& u, int wr, int wc, int fr, int fq) const {
        const int row0 = u.pm * BM + wr * 64 + fr; const int col0 = u.pn * HALF + wc * 32 + 8 * fq;
#pragma unroll
        for (int ai = 0; ai < 2; ++ai)
#pragma unroll
            for (int m = 0; m < 4; ++m) { bf16_t* rowp = O + (size_t)(row0 + ai * HALF + m * 16) * ldc + col0;
                const f32x4 g0 = acc[ai][0][m][0], g1 = acc[ai][0][m][1], u0 = acc[ai][1][m][0], u1 = acc[ai][1][m][1];
                u32x4 w; w.x = cvt_pk_bf16(sg(g0[0], u0[0]), sg(g0[1], u0[1])); w.y = cvt_pk_bf16(sg(g0[2], u0[2]), sg(g0[3], u0[3]));
                w.z = cvt_pk_bf16(sg(g1[0], u1[0]), sg(g1[1], u1[1])); w.w = cvt_pk_bf16(sg(g1[2], u1[2]), sg(g1[3], u1[3]));
                *(u32x4*)rowp = w; }
    }
};

struct EpiProj {
    static constexpr bool PERM = true, AFTER_DRAIN = false;
    bf16_t* O; int ldc; const float* rope; int rope_end, nr_lo, nr_hi, qs_end; float qscale; float* wi; int wi_col; float wscale;
    __device__ __forceinline__ void operator()(const f32x4 (&acc)[2][2][4][2], const Unit& u, int wr, int wc, int fr, int fq) const {
        const int row0 = u.pm * BM + wr * 64 + fr;
#pragma unroll
        for (int bj = 0; bj < 2; ++bj) {
            const int c8 = u.pn * BM + bj * HALF + wc * 32 + 8 * fq;
            const bool do_rope = (c8 < rope_end) && !(c8 >= nr_lo && c8 < nr_hi) && ((c8 & 63) < 16);
            const float sc = (c8 < qs_end) ? qscale : 1.0f;
            const int j0 = 4 * ((c8 >> 3) & 1);
            const bool do_wi = (c8 == wi_col);
#pragma unroll
            for (int ai = 0; ai < 2; ++ai)
#pragma unroll
                for (int m = 0; m < 4; ++m) { const int row = row0 + ai * HALF + m * 16;
                    f32x4 v0 = acc[ai][bj][m][0], v1 = acc[ai][bj][m][1];
                    if (do_rope) { const f32x4 cs = *(const f32x4*)(rope + (size_t)row * 16 + j0), sn = *(const f32x4*)(rope + (size_t)row * 16 + 8 + j0);
                        const f32x4 a0 = v0, a1 = v1;
                        v0[0] = a0[0] * cs[0] - a0[1] * sn[0]; v0[1] = a0[1] * cs[0] + a0[0] * sn[0];
                        v0[2] = a0[2] * cs[1] - a0[3] * sn[1]; v0[3] = a0[3] * cs[1] + a0[2] * sn[1];
                        v1[0] = a1[0] * cs[2] - a1[1] * sn[2]; v1[1] = a1[1] * cs[2] + a1[0] * sn[2];
                        v1[2] = a1[2] * cs[3] - a1[3] * sn[3]; v1[3] = a1[3] * cs[3] + a1[2] * sn[3]; }
                    v0 = v0 * sc; v1 = v1 * sc;
                    if (do_wi) { *(f32x4*)(wi + (size_t)row * 8) = v0 * wscale; *(f32x4*)(wi + (size_t)row * 8 + 4) = v1 * wscale; }
                    u32x4 w; w.x = cvt_pk_bf16(v0[0], v0[1]); w.y = cvt_pk_bf16(v0[2], v0[3]); w.z = cvt_pk_bf16(v1[0], v1[1]); w.w = cvt_pk_bf16(v1[2], v1[3]);
                    *(u32x4*)(O + (size_t)row * ldc + c8) = w; }
        }
    }
};

template <class Epi, class Sched, bool ALIGN_EPI = false, bool SP2 = false>
__device__ __forceinline__ void gemm_phase(PG8_LAS unsigned char* lds, const Gemm g, const Sched& S, const Epi& E) {
    int tid_l = threadIdx.x; asm volatile("" : "+v"(tid_l));
    const int tid = tid_l, wid = __builtin_amdgcn_readfirstlane(tid >> 6), lane = tid & 63, wr = wid >> 2, wc = wid & 3, fr = lane & 15, fq = lane >> 4;
    const int K = g.K, nt = K / BK;
    unsigned voffA[2], voffB[2];
#pragma unroll
    for (int i = 0; i < 2; ++i) { int R, C; stage_rc(tid * 16 + i * 8192, R, C); const int Rb = Epi::PERM ? ((R & ~31) + perm32(R & 31)) : R;
        voffA[i] = (unsigned)(R * K + C) * 2u; voffB[i] = (unsigned)(Rb * K + C) * 2u; }
    const size_t kstep = (size_t)(BK * 2);
    const size_t hstep = (size_t)HALF * K * 2;
    const size_t tstep = 2 * hstep;
    const unsigned ldsw = (unsigned)wid * 1024u;
    const int aoff = lds_byte(wr * 64 + fr, fq * 8), boff = lds_byte(wc * 32 + fr, fq * 8);
#define PG8_SA(b, h) (((b) * 2 + (h)) * HTB)
#define PG8_SB(b, h) ((4 + (b) * 2 + (h)) * HTB)
#define PG8_STAGE(bufoff, gbase, voff) do { _Pragma("unroll") for (int _i = 0; _i < 2; ++_i) \
        __builtin_amdgcn_global_load_lds((const unsigned*)((const char*)(gbase) + (voff)[_i]), (PG8_LAS unsigned*)(lds + (bufoff) + ldsw + _i * 8192), 16, 0, 0); } while (0)
#define PG8_LDA(dst, b, h) do { _Pragma("unroll") for (int m = 0; m < 4; ++m) _Pragma("unroll") for (int k = 0; k < 2; ++k) dst[m][k] = *(const PG8_LAS bf16x8*)(lds + PG8_SA(b, h) + aoff + m * 2048 + k * 1024); } while (0)
#define PG8_LDB(dst, b, h) do { _Pragma("unroll") for (int n = 0; n < 2; ++n) _Pragma("unroll") for (int k = 0; k < 2; ++k) dst[n][k] = *(const PG8_LAS bf16x8*)(lds + PG8_SB(b, h) + boff + n * 2048 + k * 1024); } while (0)
#define PG8_MMA(ai, bj, At, Bt) do { __builtin_amdgcn_s_setprio(1); _Pragma("unroll") for (int m = 0; m < 4; ++m) _Pragma("unroll") for (int n = 0; n < 2; ++n) _Pragma("unroll") for (int k = 0; k < 2; ++k) \
        acc[ai][bj][m][n] = __builtin_amdgcn_mfma_f32_16x16x32_bf16(Bt[n][k], At[m][k], acc[ai][bj][m][n], 0, 0, 0); __builtin_amdgcn_s_setprio(0); } while (0)
#define PG8_WAIT_V(n) asm volatile("s_waitcnt vmcnt(" #n ")" ::: "memory")
#define PG8_WAIT_L(n) asm volatile("s_waitcnt lgkmcnt(" #n ")" ::: "memory")
#define PG8_BAR __builtin_amdgcn_s_barrier()
#define PG8_SCHED __builtin_amdgcn_sched_barrier(0)
    Unit cur, nxt; int ui = 0;
    if (!S.next(0, cur)) return;
    f32x4 acc[2][2][4][2];
#pragma unroll
    for (int a = 0; a < 2; ++a)
#pragma unroll
        for (int b = 0; b < 2; ++b)
#pragma unroll
            for (int m = 0; m < 4; ++m)
#pragma unroll
                for (int n = 0; n < 2; ++n) acc[a][b][m][n] = (f32x4){0.f, 0.f, 0.f, 0.f};
    bf16x8 At[4][2], B0[2][2], B1[2][2];
    const char* cA = (const char*)g.A + (size_t)cur.pm * tstep; const char* cB = (const char*)g.Bt + (size_t)cur.pn * tstep;
    S.a_ready(cur);
    if constexpr (SP2) {
        PG8_STAGE(PG8_SB(0, 0), cB, voffB); PG8_STAGE(PG8_SB(0, 1), cB + hstep, voffB); PG8_STAGE(PG8_SA(0, 0), cA, voffA); PG8_STAGE(PG8_SA(0, 1), cA + hstep, voffA);
        if (wr == 1) PG8_BAR;
        PG8_WAIT_V(2); PG8_BAR;
        PG8_STAGE(PG8_SB(1, 0), cB + kstep, voffB); PG8_STAGE(PG8_SA(1, 0), cA + kstep, voffA); PG8_STAGE(PG8_SB(1, 1), cB + hstep + kstep, voffB);
        PG8_WAIT_V(6); PG8_BAR;
    } else {
        PG8_STAGE(PG8_SB(0, 0), cB, voffB); PG8_STAGE(PG8_SA(0, 0), cA, voffA); PG8_STAGE(PG8_SB(0, 1), cB + hstep, voffB); PG8_STAGE(PG8_SA(0, 1), cA + hstep, voffA);
        if (wr == 1) PG8_BAR;
        PG8_WAIT_V(4); PG8_BAR;
        PG8_STAGE(PG8_SB(1, 0), cB + kstep, voffB); PG8_STAGE(PG8_SA(1, 0), cA + kstep, voffA); PG8_STAGE(PG8_SB(1, 1), cB + hstep + kstep, voffB);
        PG8_WAIT_V(6); PG8_BAR;
    }
    for (;;) {
        const bool has_next = S.next(ui + 1, nxt);
        const char* nA = has_next ? (const char*)g.A + (size_t)nxt.pm * tstep : cA; const char* nB = has_next ? (const char*)g.Bt + (size_t)nxt.pn * tstep : cB;
        for (int t = 0; t < nt; t += 2) {
            const bool last = (t == nt - 2);
            const char* a1 = cA + (size_t)(t + 1) * kstep;
            const char* a2 = last ? nA : cA + (size_t)(t + 2) * kstep; const char* b2 = last ? nB : cB + (size_t)(t + 2) * kstep;
            const char* a3 = a2 + kstep; const char* b3 = b2 + kstep;
            if (last && has_next) S.a_ready(nxt);
            if constexpr (SP2) {
            PG8_LDB(B0, 0, 0); PG8_LDB(B1, 0, 1); PG8_SCHED; PG8_LDA(At, 0, 0); PG8_STAGE(PG8_SA(1, 1), a1 + hstep, voffA);
            PG8_WAIT_V(8); PG8_WAIT_L(0); PG8_BAR; PG8_MMA(0, 0, At, B0); PG8_MMA(0, 1, At, B1); PG8_BAR; PG8_SCHED;
            PG8_LDA(At, 0, 1); PG8_STAGE(PG8_SB(0, 0), b2, voffB); PG8_STAGE(PG8_SB(0, 1), b2 + hstep, voffB); PG8_STAGE(PG8_SA(0, 0), a2, voffA);
            PG8_WAIT_V(8); PG8_WAIT_L(0); PG8_BAR; PG8_MMA(1, 0, At, B0); PG8_MMA(1, 1, At, B1); PG8_BAR; PG8_SCHED;
            PG8_LDB(B0, 1, 0); PG8_LDB(B1, 1, 1); PG8_SCHED; PG8_LDA(At, 1, 0); PG8_STAGE(PG8_SA(0, 1), a2 + hstep, voffA);
            PG8_WAIT_V(8); PG8_WAIT_L(0); PG8_BAR; PG8_MMA(0, 0, At, B0); PG8_MMA(0, 1, At, B1); PG8_BAR; PG8_SCHED;
            PG8_LDA(At, 1, 1); PG8_STAGE(PG8_SB(1, 0), b3, voffB); PG8_STAGE(PG8_SB(1, 1), b3 + hstep, voffB); PG8_STAGE(PG8_SA(1, 0), a3, voffA);
            PG8_WAIT_V(8); PG8_WAIT_L(0); PG8_BAR; PG8_MMA(1, 0, At, B0); PG8_MMA(1, 1, At, B1); PG8_BAR; PG8_SCHED;
            } else {
            PG8_LDB(B0, 0, 0); PG8_SCHED; PG8_LDA(At, 0, 0); PG8_STAGE(PG8_SA(1, 1), a1 + hstep, voffA);
            PG8_WAIT_L(8); PG8_BAR; PG8_WAIT_L(0); PG8_MMA(0, 0, At, B0); PG8_BAR; PG8_SCHED;
            PG8_LDB(B1, 0, 1); PG8_STAGE(PG8_SB(0, 0), b2, voffB);
            PG8_BAR; PG8_WAIT_L(0); PG8_MMA(0, 1, At, B1); PG8_BAR;
            PG8_LDA(At, 0, 1); PG8_STAGE(PG8_SA(0, 0), a2, voffA);
            PG8_BAR; PG8_WAIT_L(0); PG8_MMA(1, 0, At, B0); PG8_BAR; PG8_SCHED;
            PG8_STAGE(PG8_SB(0, 1), b2 + hstep, voffB);
            PG8_WAIT_V(6); PG8_BAR; PG8_MMA(1, 1, At, B1); PG8_BAR;
            PG8_LDB(B0, 1, 0); PG8_SCHED; PG8_LDA(At, 1, 0); PG8_STAGE(PG8_SA(0, 1), a2 + hstep, voffA);
            PG8_WAIT_L(8); PG8_BAR; PG8_WAIT_L(0); PG8_MMA(0, 0, At, B0); PG8_BAR; PG8_SCHED;
            PG8_LDB(B1, 1, 1); PG8_STAGE(PG8_SB(1, 0), b3, voffB);
            PG8_BAR; PG8_WAIT_L(0); PG8_MMA(0, 1, At, B1); PG8_BAR;
            PG8_LDA(At, 1, 1); PG8_STAGE(PG8_SA(1, 0), a3, voffA);
            PG8_BAR; PG8_WAIT_L(0); PG8_MMA(1, 0, At, B0); PG8_BAR; PG8_SCHED;
            PG8_STAGE(PG8_SB(1, 1), b3 + hstep, voffB);
            PG8_WAIT_V(6); PG8_BAR; PG8_MMA(1, 1, At, B1); PG8_BAR;
            }
        }
        if constexpr (ALIGN_EPI) { if (wr == 0) PG8_BAR; }
        if constexpr (!Epi::AFTER_DRAIN) { E(acc, cur, wr, wc, fr, fq); S.done(cur); }
        if (!has_next) break;
#pragma unroll
        for (int a = 0; a < 2; ++a)
#pragma unroll
            for (int b = 0; b < 2; ++b)
#pragma unroll
                for (int m = 0; m < 4; ++m)
#pragma unroll
                    for (int n = 0; n < 2; ++n) acc[a][b][m][n] = (f32x4){0.f, 0.f, 0.f, 0.f};
        cur = nxt; cA = nA; cB = nB; ++ui;
        if constexpr (ALIGN_EPI) { if (wr == 1) PG8_BAR; }
    }
    PG8_WAIT_V(0);
    if constexpr (!ALIGN_EPI) { if (wr == 0) PG8_BAR; }
    PG8_BAR;
    if constexpr (Epi::AFTER_DRAIN) { E.fused(acc, cur, wr, wc, fr, fq, lds, wid, lane); S.done(cur); }
#undef PG8_SA
#undef PG8_SB
#undef PG8_STAGE
#undef PG8_LDA
#undef PG8_LDB
#undef PG8_MMA
#undef PG8_WAIT_V
#undef PG8_WAIT_L
#undef PG8_BAR
#undef PG8_SCHED
}
}

namespace attn_body {
using bf16=__hip_bfloat16;
using bf16x8=__attribute__((ext_vector_type(8)))short;
using s16x4=__attribute__((ext_vector_type(4)))short;
using f32x16=__attribute__((ext_vector_type(16)))float;
using u32x4=__attribute__((ext_vector_type(4)))unsigned;
constexpr int BATCH=8,NVH=32,SEQ=4096,D=64,QKVP=3072,OP=2048;
constexpr int NW=8,QBLK=32,QB=QBLK*NW,KVBLK=64,NQB=SEQ/QB;
constexpr int ATTN_UNIT_ROWS=QB;
__device__ __forceinline__ int crow(int r,int hi){return (r&3)+8*(r>>2)+4*hi;}
#define SBAR() __builtin_amdgcn_sched_barrier(0)
__device__ __forceinline__ void cmask(f32x16&p0,f32x16&p1,int jb,int qrel,int hi){
  const float NEG=-INFINITY; int kb=64*jb+4*hi;
  #pragma unroll
  for(int r=0;r<16;++r){int kv=kb+(r&3)+8*(r>>2); if(kv>qrel)p0[r]=NEG; if(kv+32>qrel)p1[r]=NEG;}
}

constexpr int NSLOT=3, SLOTB=8192;
constexpr int LDS_K=0, LDS_V=NSLOT*SLOTB, LDS_WS=2*NSLOT*SLOTB, LDS_OST=LDS_WS+NW*64*4, LDS_BYTES=LDS_OST+NW*4096;
constexpr float C2=0.125f*1.4426950408889634f;
__device__ __forceinline__ void glds16(const void*gsrc,unsigned lds_dst){unsigned keep;
  asm volatile("s_mov_b32 %0, m0\n\ts_mov_b32 m0, %2\n\ts_nop 0\n\tglobal_load_lds_dwordx4 %1, off\n\ts_mov_b32 m0, %0":"=&s"(keep):"v"(gsrc),"s"(lds_dst):"memory");}
__device__ __forceinline__ float max3f(float a,float b,float c){float r;asm("v_max3_f32 %0, %1, %2, %3":"=v"(r):"v"(a),"v"(b),"v"(c));return r;}
__device__ __forceinline__ float max2f(float a,float b){float r;asm("v_max_f32_e32 %0, %1, %2":"=v"(r):"v"(a),"v"(b));return r;}
__device__ __forceinline__ float fadd_s(float a,float b){float r;asm("v_add_f32_e32 %0, %1, %2":"=v"(r):"v"(a),"v"(b));return r;}
__device__ __forceinline__ float fsub_s(float a,float b){float r;asm("v_sub_f32_e32 %0, %1, %2":"=v"(r):"v"(a),"v"(b));return r;}
typedef float f32x2_t __attribute__((ext_vector_type(2))); typedef __bf16 bf16x2_t __attribute__((ext_vector_type(2)));
__device__ __forceinline__ unsigned cvtpk_s(float lo,float hi){f32x2_t v={lo,hi};bf16x2_t b=__builtin_convertvector(v,bf16x2_t);return __builtin_bit_cast(unsigned,b);}
#define WAIT_BAR(N) asm volatile("s_waitcnt vmcnt(" #N ") lgkmcnt(0)\n\ts_barrier":::"memory")

__device__ __forceinline__ void qkt(f32x16&p0,f32x16&p1,const char*Kslot,const bf16x8*qr,const f32x16&negm,int r32,int hi){
  const char*kb=Kslot+hi*1024+r32*16;
  #pragma unroll
  for(int d0=0;d0<4;++d0){
    const bf16x8 b0=*reinterpret_cast<const bf16x8*>(kb+d0*2048);
    const bf16x8 b1=*reinterpret_cast<const bf16x8*>(kb+d0*2048+512);
    if(d0==0){p0=__builtin_amdgcn_mfma_f32_32x32x16_bf16(b0,qr[0],negm,0,0,0);p1=__builtin_amdgcn_mfma_f32_32x32x16_bf16(b1,qr[0],negm,0,0,0);}
    else{p0=__builtin_amdgcn_mfma_f32_32x32x16_bf16(b0,qr[d0],p0,0,0,0);p1=__builtin_amdgcn_mfma_f32_32x32x16_bf16(b1,qr[d0],p1,0,0,0);}}
}
typedef __attribute__((address_space(3))) const char* lds_cptr;
typedef short v4i16_t __attribute__((ext_vector_type(4)));
__device__ __forceinline__ void kload8(bf16x8*kf,lds_cptr kp){
  kf[0]=*(const __attribute__((address_space(3))) bf16x8*)(kp);      kf[1]=*(const __attribute__((address_space(3))) bf16x8*)(kp+512);
  kf[2]=*(const __attribute__((address_space(3))) bf16x8*)(kp+2048); kf[3]=*(const __attribute__((address_space(3))) bf16x8*)(kp+2560);
  kf[4]=*(const __attribute__((address_space(3))) bf16x8*)(kp+4096); kf[5]=*(const __attribute__((address_space(3))) bf16x8*)(kp+4608);
  kf[6]=*(const __attribute__((address_space(3))) bf16x8*)(kp+6144); kf[7]=*(const __attribute__((address_space(3))) bf16x8*)(kp+6656);
}
__device__ __forceinline__ void kload2(bf16x8*kf,lds_cptr kp,int j){ kf[2*j]=*(const __attribute__((address_space(3))) bf16x8*)(kp+j*2048); kf[2*j+1]=*(const __attribute__((address_space(3))) bf16x8*)(kp+j*2048+512); }
__device__ __forceinline__ s16x4 vtr(lds_cptr p){ return __builtin_bit_cast(s16x4,__builtin_amdgcn_ds_read_tr16_b64_v4i16((__attribute__((address_space(3))) v4i16_t*)p)); }
__device__ __forceinline__ float rowmax(const f32x16&p0,const f32x16&p1){
  float a=max3f(p0[0],p0[1],p1[0]),b=max3f(p0[2],p0[3],p1[1]);a=max3f(a,p1[2],p1[3]);
  #pragma unroll
  for(int r=4;r<16;r+=4){a=max3f(a,p0[r],p0[r+1]);b=max3f(b,p0[r+2],p0[r+3]);a=max3f(a,p1[r],p1[r+1]);b=max3f(b,p1[r+2],p1[r+3]);}
  const float m=max2f(a,b);
  auto rr=__builtin_amdgcn_permlane32_swap(__float_as_uint(m),__float_as_uint(m),false,false);
  return max2f(__uint_as_float(rr[0]),__uint_as_float(rr[1]));
}
__device__ __forceinline__ void pv(f32x16*o,int vb,bf16x8 pa0,bf16x8 pa1,bf16x8 pa2,bf16x8 pa3){
  #pragma unroll
  for(int d0=0;d0<2;++d0){s16x4 lo[4],hi[4];
    #pragma unroll
    for(int ks=0;ks<4;++ks){
      asm volatile("ds_read_b64_tr_b16 %0,%1 offset:%c2":"=&v"(lo[ks]):"v"(vb),"i"(d0*4096+ks*1024):"memory");
      asm volatile("ds_read_b64_tr_b16 %0,%1 offset:%c2":"=&v"(hi[ks]):"v"(vb),"i"(d0*4096+ks*1024+512):"memory");}
    asm volatile("s_waitcnt lgkmcnt(0)":::"memory");SBAR();
    #define PK(k) (bf16x8){lo[k][0],lo[k][1],lo[k][2],lo[k][3],hi[k][0],hi[k][1],hi[k][2],hi[k][3]}
    o[d0]=__builtin_amdgcn_mfma_f32_32x32x16_bf16(pa0,PK(0),o[d0],0,0,0);
    o[d0]=__builtin_amdgcn_mfma_f32_32x32x16_bf16(pa1,PK(1),o[d0],0,0,0);
    o[d0]=__builtin_amdgcn_mfma_f32_32x32x16_bf16(pa2,PK(2),o[d0],0,0,0);
    o[d0]=__builtin_amdgcn_mfma_f32_32x32x16_bf16(pa3,PK(3),o[d0],0,0,0);
    #undef PK
  }
}

#ifndef ATTN_STORE16
#define ATTN_STORE16(p,v) (*(u32x4*)(p)=(v))
#endif
template<int THRL> __device__ __forceinline__ void attn_unit(int b,int qoff,int koff,int voff,int ooff,int qb,const bf16*Q,const bf16*__restrict__ K,const bf16*__restrict__ V,bf16*O,char*shm){
  int tid_l=threadIdx.x; asm volatile("":"+v"(tid_l)); const int tid=tid_l,lane=tid&63,r32=lane&31,hi=lane>>5; const int wid=__builtin_amdgcn_readfirstlane(tid>>6);
  const long rowbase=(long)b*SEQ; const int q0=qb*QB;
  const bf16*Qw=Q+(rowbase+q0+wid*QBLK)*QKVP+qoff;
  const bf16*Kh=K+rowbase*QKVP+koff,*Vh=V+rowbase*QKVP+voff;
  const unsigned lds0=(unsigned)(uintptr_t)shm;
  float*wsf=(float*)(shm+LDS_WS)+wid*64;
  const bf16*ksrc=Kh+(long)lane*QKVP+wid*8;
  const bf16*vsrc=Vh+(long)(16*(wid&3)+(lane>>2))*QKVP+(wid>>2)*32+(lane&3)*8;
  const unsigned kdst=lds0+LDS_K+wid*1024, vdst=lds0+LDS_V+wid*1024;
  #define DMA_K(t,slot) glds16(ksrc+(long)(t)*KVBLK*QKVP,(unsigned)__builtin_amdgcn_readfirstlane(kdst+(slot)))
  #define DMA_V(t,slot) glds16(vsrc+(long)(t)*KVBLK*QKVP,(unsigned)__builtin_amdgcn_readfirstlane(vdst+(slot)))
  const int vb0=(int)(lds0+LDS_V)+((lane>>4)&1)*32+(lane&3)*8+(4*hi+((lane&15)>>2))*64;
  const char*Kbase=shm+LDS_K; bf16x8 kf[8];
  const lds_cptr shm3=(lds_cptr)shm; const lds_cptr kp0=shm3+LDS_K+hi*1024+r32*16; const lds_cptr vp0=shm3+LDS_V+((lane>>4)&1)*32+(lane&3)*8+(4*hi+((lane&15)>>2))*64;
  const int NT=(q0+QB)/KVBLK;
  DMA_K(0,0);DMA_V(0,0);DMA_K(1,SLOTB);
  bf16x8 qr[4];
  #pragma unroll
  for(int d0=0;d0<4;++d0)qr[d0]=*reinterpret_cast<const bf16x8*>(&Qw[(long)r32*QKVP+d0*16+hi*8]);
  float mhat=0.f,l_reg=0.f;f32x16 o[2];o[0]=f32x16{};o[1]=f32x16{};f32x16 negm=f32x16{};asm volatile("":"+v"(negm));
  const int qrel=wid*QBLK+r32;
  #define CMASK(P0,P1,t) do{int jb_=(t)-(NT-4); if(jb_>=0)cmask(P0,P1,jb_,qrel,hi);}while(0)
  bool resc=false;
  #define START(P0,P1) do{ const float rm=rowmax(P0,P1); resc=false; \
    { const float dl=rm; mhat=fadd_s(mhat,dl); \
      _Pragma("unroll") for(int r=0;r<16;++r){P0[r]=fsub_s(P0[r],dl);P1[r]=fsub_s(P1[r],dl);} \
      _Pragma("unroll") for(int r=0;r<16;++r)negm[r]=-mhat; asm volatile("":"+v"(negm)); } \
    _Pragma("unroll") for(int r=0;r<16;++r)P0[r]=__builtin_amdgcn_exp2f(P0[r]); }while(0)
  #define RESC() do{ if(resc){ asm volatile("s_waitcnt lgkmcnt(0)":::"memory"); \
      _Pragma("unroll") for(int d_=0;d_<2;++d_) _Pragma("unroll") for(int r=0;r<16;++r)o[d_][r]*=wsf[crow(r,hi)]; } }while(0)
  f32x16 pA0,pA1,pB0,pB1;
  int sl_prev=0,sl_cur=0,sl_next=SLOTB;
  #define ROT() do{sl_prev=sl_cur;sl_cur=sl_next;sl_next=(sl_next==(NSLOT-1)*SLOTB)?0:sl_next+SLOTB;}while(0)
  DMA_K(2,2*SLOTB);
  WAIT_BAR(3);
  qkt(pA0,pA1,Kbase,qr,negm,r32,hi);asm volatile("s_nop 15\n\ts_nop 7":"+v"(pA0),"+v"(pA1));CMASK(pA0,pA1,0);
  START(pA0,pA1);
  _Pragma("unroll") for(int r=0;r<16;++r)pA1[r]=__builtin_amdgcn_exp2f(pA1[r]);
  WAIT_BAR(0);
  DMA_K(3,0);DMA_V(1,SLOTB);
  ROT();
  kload8(kf,kp0+sl_cur);
  WAIT_BAR(2);
  s16x4 vlo[8],vhi[8]; u32x4 pw0,pw1,pw2,pw3;
  #define PKW(P,B) cvtpk_s(P[B],P[B+1])
  #define PAF(k) __builtin_bit_cast(bf16x8,pw##k)
  #define VFR(i) (bf16x8){vlo[i][0],vlo[i][1],vlo[i][2],vlo[i][3],vhi[i][0],vhi[i][1],vhi[i][2],vhi[i][3]}
  #define PIN(x) asm volatile("":"+v"(x))
  #define MX3(a,b,c) __builtin_fmaxf(__builtin_fmaxf((a),(b)),(c))
  #define GAPA(MF,A0,A1,A2,A3,W0,W1,PW) do{ MF; sacc+=A0; sacc+=A1; sacc+=A2; sacc+=A3; PIN(sacc); W0; W1; PIN(PW); SBAR(); }while(0)
  #define EX(v) __builtin_amdgcn_exp2f(v)
  #define GAPB(MF,X,B) do{ MF; X[B]=EX(X[B]); X[B+1]=EX(X[B+1]); X[B+2]=EX(X[B+2]); X[B+3]=EX(X[B+3]); PIN(X); SBAR(); }while(0)
  #define VRD(i) do{ vlo[i]=vtr(vp_+(((i)>>2)*4096+((i)&3)*1024)); vhi[i]=vtr(vp_+(((i)>>2)*4096+((i)&3)*1024+512)); }while(0)
  #define KRD(G,j) do{ if(G){ kload2(kf,kp0+sl_next,j); SBAR(); } }while(0)
  #define STEP(C0,C1,P0,P1,t,GK,GV,GL) do{ SBAR(); \
    const lds_cptr vp_=vp0+sl_prev; \
    VRD(0); SBAR(); float sacc=(P0[0]+P0[1]); \
    GAPA(C0=__builtin_amdgcn_mfma_f32_32x32x16_bf16(kf[0],qr[0],negm,0,0,0), P0[2],P0[3],P0[4],P0[5],     pw0[0]=PKW(P0,0), pw0[1]=PKW(P0,2), pw0); \
    VRD(4); SBAR(); GAPA(C1=__builtin_amdgcn_mfma_f32_32x32x16_bf16(kf[1],qr[0],negm,0,0,0), P0[6],P0[7],P0[8],P0[9],     pw0[2]=PKW(P0,4), pw0[3]=PKW(P0,6), pw0); \
    VRD(1); SBAR(); GAPA(C0=__builtin_amdgcn_mfma_f32_32x32x16_bf16(kf[2],qr[1],C0,0,0,0),   P0[10],P0[11],P0[12],P0[13], pw1[0]=PKW(P0,8), pw1[1]=PKW(P0,10), pw1); \
    VRD(5); SBAR(); GAPA(C1=__builtin_amdgcn_mfma_f32_32x32x16_bf16(kf[3],qr[1],C1,0,0,0),   P0[14],P0[15],P1[0],P1[1],   pw1[2]=PKW(P0,12),pw1[3]=PKW(P0,14), pw1); \
    VRD(2); SBAR(); GAPA(C0=__builtin_amdgcn_mfma_f32_32x32x16_bf16(kf[4],qr[2],C0,0,0,0),   P1[2],P1[3],P1[4],P1[5],     pw2[0]=PKW(P1,0), pw2[1]=PKW(P1,2), pw2); \
    VRD(6); SBAR(); GAPA(C1=__builtin_amdgcn_mfma_f32_32x32x16_bf16(kf[5],qr[2],C1,0,0,0),   P1[6],P1[7],P1[8],P1[9],     pw2[2]=PKW(P1,4), pw2[3]=PKW(P1,6), pw2); \
    VRD(3); SBAR(); GAPA(C0=__builtin_amdgcn_mfma_f32_32x32x16_bf16(kf[6],qr[3],C0,0,0,0),   P1[10],P1[11],P1[12],P1[13], pw3[0]=PKW(P1,8), pw3[1]=PKW(P1,10), pw3); \
    VRD(7); SBAR(); GAPA(C1=__builtin_amdgcn_mfma_f32_32x32x16_bf16(kf[7],qr[3],C1,0,0,0),   P1[14],P1[15],0.f,0.f,       pw3[2]=PKW(P1,12),pw3[3]=PKW(P1,14), pw3); \
    l_reg+=sacc; \
    if(GK){DMA_K((t)+3,sl_cur);} if(GV){DMA_V((t)+1,sl_next);} \
    CMASK(C0,C1,t); \
    { float a=MX3(C0[0],C0[1],C1[0]),b=MX3(C0[2],C0[3],C1[1]); a=MX3(a,C1[2],C1[3]); \
      _Pragma("unroll") for(int r=4;r<16;r+=4){a=MX3(a,C0[r],C0[r+1]);b=MX3(b,C0[r+2],C0[r+3]);a=MX3(a,C1[r],C1[r+1]);b=MX3(b,C1[r+2],C1[r+3]);} \
      float rm=__builtin_fmaxf(a,b); { auto rr=__builtin_amdgcn_permlane32_swap(__float_as_uint(rm),__float_as_uint(rm),false,false); rm=__builtin_fmaxf(__uint_as_float(rr[0]),__uint_as_float(rr[1])); } \
      resc=false; \
      if(__builtin_expect(__any(rm>(float)THRL),0)){ const float dl=__builtin_fmaxf(rm,0.f); mhat+=dl; \
        _Pragma("unroll") for(int r=0;r<16;++r){C0[r]-=dl;C1[r]-=dl;} \
        _Pragma("unroll") for(int r=0;r<16;++r)negm[r]=-mhat; asm volatile("":"+v"(negm)); \
        const float f=__builtin_amdgcn_exp2f(-dl); l_reg*=f; if(hi==0)wsf[r32]=f; resc=true; } } \
    SBAR(); \
    GAPB(o[0]=__builtin_amdgcn_mfma_f32_32x32x16_bf16(PAF(0),VFR(0),o[0],0,0,0), C0,0); \
    GAPB(o[1]=__builtin_amdgcn_mfma_f32_32x32x16_bf16(PAF(0),VFR(4),o[1],0,0,0), C0,4); \
    KRD(GL,0); GAPB(o[0]=__builtin_amdgcn_mfma_f32_32x32x16_bf16(PAF(1),VFR(1),o[0],0,0,0), C0,8); \
    KRD(GL,1); GAPB(o[1]=__builtin_amdgcn_mfma_f32_32x32x16_bf16(PAF(1),VFR(5),o[1],0,0,0), C0,12); \
    KRD(GL,2); GAPB(o[0]=__builtin_amdgcn_mfma_f32_32x32x16_bf16(PAF(2),VFR(2),o[0],0,0,0), C1,0); \
    KRD(GL,3); GAPB(o[1]=__builtin_amdgcn_mfma_f32_32x32x16_bf16(PAF(2),VFR(6),o[1],0,0,0), C1,4); \
    GAPB(o[0]=__builtin_amdgcn_mfma_f32_32x32x16_bf16(PAF(3),VFR(3),o[0],0,0,0), C1,8); \
    GAPB(o[1]=__builtin_amdgcn_mfma_f32_32x32x16_bf16(PAF(3),VFR(7),o[1],0,0,0), C1,12); \
    }while(0)
  int t=1;
  #undef CMASK
  #define CMASK(P0,P1,t) do{}while(0)
  for(;t+5<NT;t+=2){
    STEP(pB0,pB1,pA0,pA1,t,true,true,true);     WAIT_BAR(2); RESC(); ROT();
    STEP(pA0,pA1,pB0,pB1,t+1,true,true,true);   WAIT_BAR(2); RESC(); ROT();
  }
  #undef CMASK
  #define CMASK(P0,P1,t) do{int jb_=(t)-(NT-4); if(jb_>=0)cmask(P0,P1,jb_,qrel,hi);}while(0)
  #define ENDW(tt) do{ if((tt)+3<NT){WAIT_BAR(2);} else if((tt)+2<NT){WAIT_BAR(1);} else {WAIT_BAR(0);} }while(0)
  for(;t+1<NT;t+=2){
    STEP(pB0,pB1,pA0,pA1,t,(t+3<NT),(t+1<NT),(t+1<NT));       ENDW(t);   RESC(); ROT();
    STEP(pA0,pA1,pB0,pB1,t+1,(t+4<NT),(t+2<NT),(t+2<NT));     ENDW(t+1); RESC(); ROT();
  }
  STEP(pB0,pB1,pA0,pA1,NT-1,false,false,false); RESC();
  { float sacc=pB0[0]+pB0[1]; _Pragma("unroll") for(int r=2;r<16;++r)sacc+=pB0[r]; _Pragma("unroll") for(int r=0;r<16;++r)sacc+=pB1[r]; l_reg+=sacc;
    pw0=(u32x4){PKW(pB0,0),PKW(pB0,2),PKW(pB0,4),PKW(pB0,6)};pw1=(u32x4){PKW(pB0,8),PKW(pB0,10),PKW(pB0,12),PKW(pB0,14)};pw2=(u32x4){PKW(pB1,0),PKW(pB1,2),PKW(pB1,4),PKW(pB1,6)};pw3=(u32x4){PKW(pB1,8),PKW(pB1,10),PKW(pB1,12),PKW(pB1,14)};
    SBAR(); pv(o,vb0+sl_cur,PAF(0),PAF(1),PAF(2),PAF(3)); }
  #undef PKW
  #undef PAF
  #undef VFR
  #undef PIN
  #undef MX3
  #undef GAPA
  #undef GAPB
  #undef EX
  #undef VRD
  #undef KRD
  #undef STEP
  #undef ENDW
  {auto rr=__builtin_amdgcn_permlane32_swap(__float_as_uint(l_reg),__float_as_uint(l_reg),false,false);l_reg=__uint_as_float(rr[0])+__uint_as_float(rr[1]);}
  if(hi==0)wsf[32+r32]=l_reg;asm volatile("s_waitcnt lgkmcnt(0)":::"memory");
  float rli[16];
  #pragma unroll
  for(int r=0;r<16;++r)rli[r]=__builtin_amdgcn_rcpf(wsf[32+crow(r,hi)]);
  bf16*Ow=O+(rowbase+q0+wid*QBLK)*OP+ooff;
  { bf16*stg=(bf16*)(shm+LDS_OST)+wid*2048;
    #pragma unroll
    for(int r=0;r<16;++r){const int orow=crow(r,hi);
      #pragma unroll
      for(int d0=0;d0<2;++d0)stg[orow*64+d0*32+r32]=__float2bfloat16(o[d0][r]*rli[r]);}
    asm volatile("s_waitcnt lgkmcnt(0)":::"memory");
    #pragma unroll
    for(int i=0;i<4;++i){const int row=i*8+(lane>>3),ch=lane&7; const u32x4 v=*(const u32x4*)(stg+row*64+ch*8); ATTN_STORE16(Ow+(long)row*OP+ch*8,v);} }
  asm volatile("s_waitcnt lgkmcnt(0)\n\ts_barrier":::"memory");
  #undef DMA_K
  #undef DMA_V
  #undef CMASK
  #undef START
  #undef RESC
  #undef ROT
}
constexpr int ATTN_LDS_BYTES=LDS_BYTES;
struct AttnTensors { const bf16* Q; const bf16* K; const bf16* V; bf16* O; };
template<int THRL=8> __device__ __forceinline__ void attn_phase(char*lds,const AttnTensors&T,int vcu,int G){
  for(int uid=vcu;uid<BATCH*NVH*NQB;uid+=G){
    const int bvh=uid&255, qb=NQB-1-(uid>>8); const int b=bvh>>5, vh=bvh&31, c=vh>>4, h=(vh>>1)&7, half=vh&1;
    attn_unit<THRL>(b,(c*8+h)*64,(c*8+h)*64,h*128+half*64,c*1024+h*128+half*64,qb,T.Q,T.K,T.V,T.O,lds);
  }
}
#undef SBAR
#undef WAIT_BAR
}

#define GAS __attribute__((address_space(1)))
#define LAS __attribute__((address_space(3)))
typedef unsigned short bf16;
typedef unsigned v4u __attribute__((ext_vector_type(4)));
typedef float f32x4 __attribute__((ext_vector_type(4)));
typedef short bf16x8 __attribute__((ext_vector_type(8)));
typedef GAS unsigned gu32;
typedef GAS unsigned long long gu64;
#define RLX_AGENT __ATOMIC_RELAXED, __HIP_MEMORY_SCOPE_AGENT
#define LDS_WAIT() asm volatile("s_waitcnt lgkmcnt(0)" ::: "memory")
#define VM_WAIT() asm volatile("s_waitcnt vmcnt(0)" ::: "memory")
__device__ __forceinline__ unsigned long long rt() { return __builtin_amdgcn_s_memrealtime(); }
__device__ __forceinline__ unsigned f2bf(float f) { unsigned u = __builtin_bit_cast(unsigned, f); return (u + 0x7fffu + ((u >> 16) & 1u)) >> 16; }
__device__ __forceinline__ unsigned pk2(float lo, float hi) { return f2bf(lo) | (f2bf(hi) << 16); }

#define XB_TMO      128
#define XB_XCNT(j)  (256  + 64 * (j))
#define XB_XSUB(j)  (1280 + 64 * (j))
#define XB_XGEN(j)  (2304 + 64 * (j))
#define XB_TOP      3328
#define XB_TOPGEN   3392
#define XCD_BAR_WORDS 3456
#define XB_SPIN_CAP (1u << 18)

__device__ __forceinline__ unsigned xb_ld(unsigned* p)              { return __hip_atomic_load(p, __ATOMIC_RELAXED, __HIP_MEMORY_SCOPE_AGENT); }
__device__ __forceinline__ unsigned xb_add(unsigned* p, unsigned v) { return __hip_atomic_fetch_add(p, v, __ATOMIC_RELAXED, __HIP_MEMORY_SCOPE_AGENT); }
__device__ __forceinline__ unsigned xb_xcc_id() { return (unsigned)__builtin_amdgcn_s_getreg((3 << 11) | 20) & 0xFu; }
#define XB_SPIN(cond, bar) do { unsigned _sp = 0; while (cond) { __builtin_amdgcn_s_sleep(1); \
    if ((++_sp & 255u) == 0u) { if (xb_ld(&(bar)[XB_TMO])) break; if (_sp > XB_SPIN_CAP) { atomicAdd(&(bar)[XB_TMO], 1u); break; } } } } while (0)

struct XcdBarrier {
    unsigned* bar; unsigned x;
    volatile LAS unsigned* st;
};

__device__ __forceinline__ XcdBarrier xcd_barrier_post(unsigned* bar, volatile LAS unsigned* st) {
    XcdBarrier b; b.bar = bar; b.x = xb_xcc_id(); b.st = st;
    if (threadIdx.x == 0) (void)xb_add(&bar[XB_XCNT(b.x)], 1u);
    return b;
}
__device__ __forceinline__ void xcd_barrier_complete(unsigned* bar, unsigned x, unsigned& nloc, unsigned& nx) {
    const unsigned G = gridDim.x * gridDim.y * gridDim.z;
    unsigned sum, cnt, mine, sp = 0u;
    for (;;) {
        sum = 0u; cnt = 0u; mine = 0u;
#pragma unroll
        for (unsigned j = 0; j < 16; ++j) { const unsigned c = xb_ld(&bar[XB_XCNT(j)]); sum += c; cnt += (c > 0u) ? 1u : 0u; mine = (j == x) ? c : mine; }
        if (sum == G) break;
        __builtin_amdgcn_s_sleep(1);
        if ((++sp & 255u) == 0u) { if (xb_ld(&bar[XB_TMO])) break; if (sp > XB_SPIN_CAP) { atomicAdd(&bar[XB_TMO], 1u); break; } }
    }
    nloc = mine > 0u ? mine : 1u; nx = cnt > 0u ? cnt : 1u;
}

__device__ __forceinline__ void xcd_barrier(const XcdBarrier& b) {
    asm volatile("s_waitcnt vmcnt(0)" ::: "memory");
    __syncthreads();
    if (threadIdx.x == 0) {
        unsigned* bar = b.bar;
        __builtin_amdgcn_s_waitcnt(0);
        unsigned nloc = b.st[0], nx = b.st[1];
        if (nloc == 0u) { xcd_barrier_complete(bar, b.x, nloc, nx); b.st[0] = nloc; b.st[1] = nx; }
        const unsigned old = xb_add(&bar[XB_XSUB(b.x)], 1u);
        const unsigned gen = old / nloc;
        if (old + 1u == (gen + 1u) * nloc) {
            __builtin_amdgcn_fence(__ATOMIC_RELEASE, "agent");
            asm volatile("s_waitcnt vmcnt(0)" ::: "memory");
            const unsigned og = xb_add(&bar[XB_TOP], 1u);
            const unsigned tg = og / nx;
            if (og + 1u == (tg + 1u) * nx) xb_add(&bar[XB_TOPGEN], 1u);
            else XB_SPIN(xb_ld(&bar[XB_TOPGEN]) == tg, bar);
            __builtin_amdgcn_fence(__ATOMIC_ACQUIRE, "agent");
            xb_add(&bar[XB_XGEN(b.x)], 1u);
            asm volatile("s_waitcnt vmcnt(0)" ::: "memory");
        } else {
            XB_SPIN(xb_ld(&bar[XB_XGEN(b.x)]) == gen, bar);
            __builtin_amdgcn_fence(__ATOMIC_ACQUIRE, "agent");
            asm volatile("s_waitcnt vmcnt(0)" ::: "memory");
        }
    }
    __syncthreads();
}

namespace dsa {
constexpr int PA = 1792, QOFF = 0, KOFF = 1024, VOFF = 1088, QIOFF = 1152, KIOFF = 1664;
constexpr int SEQ = 4096, SC_STRIDE = 4096, LDS_SC = 0, LDS_IDX = 131072, TOPK = 256;
typedef short bf16x8 __attribute__((ext_vector_type(8)));
typedef short s16x4 __attribute__((ext_vector_type(4)));
typedef float f32x16 __attribute__((ext_vector_type(16)));
typedef float f32x4 __attribute__((ext_vector_type(4)));
typedef unsigned u32x4 __attribute__((ext_vector_type(4)));
typedef unsigned short bf16_t;
#define DSA_LAS __attribute__((address_space(3)))
__device__ __forceinline__ unsigned cvtpk(float lo, float hi) { unsigned r; asm volatile("v_cvt_pk_bf16_f32 %0, %1, %2" : "=v"(r) : "v"(lo), "v"(hi)); return r; }
__device__ __forceinline__ int mbcnt64(unsigned long long m) { return (int)__builtin_amdgcn_mbcnt_hi((unsigned)(m >> 32), __builtin_amdgcn_mbcnt_lo((unsigned)m, 0u)); }
__device__ __forceinline__ s16x4 trrd(DSA_LAS const unsigned char* p) { typedef short v4i16_t __attribute__((ext_vector_type(4))); return __builtin_bit_cast(s16x4, __builtin_amdgcn_ds_read_tr16_b64_v4i16((DSA_LAS v4i16_t*)p)); }

__device__ __forceinline__ void dsa_unit(DSA_LAS unsigned char* lds, const bf16_t* __restrict__ P, const float* __restrict__ WI, bf16_t* __restrict__ O, int b, int t0, int wid, int lane) {
    const long rowbase = (long)b * SEQ;
    DSA_LAS float* SC = (DSA_LAS float*)(lds + LDS_SC);
    DSA_LAS unsigned short* myidx = (DSA_LAS unsigned short*)(lds + LDS_IDX) + wid * TOPK;
    {
        const int r = lane & 31, h8 = lane >> 5;
        const int tok = 2 * ((r >> 2) & 1) + (r >> 4), head = 4 * ((r >> 3) & 1) + (r & 3);
        bf16x8 A[2][4]; float w[2][16];
#pragma unroll
        for (int rt = 0; rt < 2; ++rt) {
            const bf16_t* qp = P + (size_t)(rowbase + t0 + 4 * rt + tok) * PA + QIOFF + head * 64 + 8 * h8;
#pragma unroll
            for (int s = 0; s < 4; ++s) A[rt][s] = *(const bf16x8*)(qp + 16 * s);
#pragma unroll
            for (int q = 0; q < 2; ++q) { const float* wp = WI + (size_t)(rowbase + t0 + 4 * rt + 2 * h8 + q) * 8; const f32x4 wa = *(const f32x4*)wp, wb = *(const f32x4*)(wp + 4);
#pragma unroll
                for (int i = 0; i < 4; ++i) { w[rt][8 * q + i] = wa[i]; w[rt][8 * q + 4 + i] = wb[i]; } }
        }
        const int ntile = (t0 + 8 + 31) >> 5;
        for (int kt = wid; kt < ntile; kt += 8) {
            const bf16_t* kp = P + (size_t)(rowbase + 32 * kt + r) * PA + KIOFF + 8 * h8;
            bf16x8 B[4];
#pragma unroll
            for (int s = 0; s < 4; ++s) B[s] = *(const bf16x8*)(kp + 16 * s);
#pragma unroll
            for (int rt = 0; rt < 2; ++rt) {
                f32x16 acc = {0.f, 0.f, 0.f, 0.f, 0.f, 0.f, 0.f, 0.f, 0.f, 0.f, 0.f, 0.f, 0.f, 0.f, 0.f, 0.f};
#pragma unroll
                for (int s = 0; s < 4; ++s) acc = __builtin_amdgcn_mfma_f32_32x32x16_bf16(A[rt][s], B[s], acc, 0, 0, 0);
                float s0 = 0.f, s1 = 0.f;
#pragma unroll
                for (int i = 0; i < 8; ++i) { s0 += w[rt][i] * __builtin_fmaxf(acc[i], 0.f); s1 += w[rt][8 + i] * __builtin_fmaxf(acc[8 + i], 0.f); }
                SC[(4 * rt + 2 * h8 + 0) * SC_STRIDE + 32 * kt + r] = s0;
                SC[(4 * rt + 2 * h8 + 1) * SC_STRIDE + 32 * kt + r] = s1;
            }
        }
    }
    __syncthreads();
    const int t = t0 + wid, n = t + 1;
    int cntq;
    if (n <= TOPK) {
#pragma unroll
        for (int j = 0; j < 4; ++j) myidx[lane + 64 * j] = (unsigned short)(lane + 64 * j);
        cntq = n;
    } else {
        float v[64];
        const DSA_LAS float* row = SC + wid * SC_STRIDE;
        const float NINF = -__builtin_inff(), PINF = __builtin_inff();
        float mx = NINF, mn = PINF;
#pragma unroll
        for (int j = 0; j < 64; ++j) { const int key = 64 * j + lane; const float x = row[key]; const bool ok = key < n; v[j] = ok ? x : NINF; mx = __builtin_fmaxf(mx, v[j]); mn = __builtin_fminf(mn, ok ? x : PINF); }
#pragma unroll
        for (int o = 1; o < 64; o <<= 1) { mx = __builtin_fmaxf(mx, __shfl_xor(mx, o)); mn = __builtin_fminf(mn, __shfl_xor(mn, o)); }
#define DSA_COUNT_GE(X, C) do { C = 0; _Pragma("unroll") for (int j_ = 0; j_ < 64; ++j_) C += __builtin_popcountll(__builtin_amdgcn_ballot_w64(v[j_] >= (X))); } while (0)
        float lo = mn, hi = mx, T; int c_hi, c_gt; bool tie;
        DSA_COUNT_GE(hi, c_hi);
        if (c_hi >= TOPK) { T = hi; tie = true; c_gt = 0; }
        else {
            for (;;) {
                const float mid = 0.5f * lo + 0.5f * hi;
                if (!(mid > lo && mid < hi)) { T = lo; tie = true; c_gt = c_hi; break; }
                int c; DSA_COUNT_GE(mid, c);
                if (c == TOPK) { T = mid; tie = false; c_gt = 0; break; }
                if (c > TOPK) lo = mid; else { hi = mid; c_hi = c; }
            }
        }
#undef DSA_COUNT_GE
        int base = 0, eqbase = 0; const int need_eq = TOPK - c_gt;
#pragma unroll
        for (int j = 0; j < 64; ++j) {
            bool sel;
            if (!tie) sel = v[j] >= T;
            else { const bool gt = v[j] > T, eq = v[j] == T; const unsigned long long me = __builtin_amdgcn_ballot_w64(eq); const int rk = eqbase + mbcnt64(me); eqbase += __builtin_popcountll(me); sel = gt || (eq && rk < need_eq); }
            const unsigned long long m = __builtin_amdgcn_ballot_w64(sel); const int pos = base + mbcnt64(m);
            if (sel && pos < TOPK) myidx[pos] = (unsigned short)(64 * j + lane);
            base += __builtin_popcountll(m);
        }
        cntq = TOPK;
    }
    asm volatile("s_waitcnt lgkmcnt(0)" ::: "memory");
    {
        const int c16 = lane & 15, g4 = lane >> 4;
        const bf16_t* qp = P + (size_t)(rowbase + t) * PA + QOFF + c16 * 64 + 8 * g4;
        const bf16x8 Q0 = *(const bf16x8*)qp, Q1 = *(const bf16x8*)(qp + 32);
        f32x4 st[16];
#pragma unroll
        for (int kt = 0; kt < 16; ++kt) {
            int kid = myidx[16 * kt + c16]; if (16 * kt + c16 >= cntq) kid = 0;
            const bf16_t* kp = P + (size_t)(rowbase + kid) * PA + KOFF + 8 * g4;
            const bf16x8 K0 = *(const bf16x8*)kp, K1 = *(const bf16x8*)(kp + 32);
            f32x4 a = {0.f, 0.f, 0.f, 0.f};
            a = __builtin_amdgcn_mfma_f32_16x16x32_bf16(K0, Q0, a, 0, 0, 0);
            a = __builtin_amdgcn_mfma_f32_16x16x32_bf16(K1, Q1, a, 0, 0, 0);
            st[kt] = a;
            if ((kt & 3) == 3) asm volatile("" ::: "memory");
        }
        float m = -__builtin_inff();
#pragma unroll
        for (int kt = 0; kt < 16; ++kt)
#pragma unroll
            for (int r = 0; r < 4; ++r) { if (16 * kt + 4 * g4 + r >= cntq) st[kt][r] = -__builtin_inff(); m = __builtin_fmaxf(m, st[kt][r]); }
        m = __builtin_fmaxf(m, __shfl_xor(m, 16)); m = __builtin_fmaxf(m, __shfl_xor(m, 32));
        float lsum = 0.f;
#pragma unroll
        for (int kt = 0; kt < 16; ++kt)
#pragma unroll
            for (int r = 0; r < 4; ++r) { st[kt][r] = __builtin_amdgcn_exp2f(st[kt][r] - m); lsum += st[kt][r]; }
        lsum += __shfl_xor(lsum, 16); lsum += __shfl_xor(lsum, 32);
        f32x4 o[4];
#pragma unroll
        for (int nd = 0; nd < 4; ++nd) o[nd] = (f32x4){0.f, 0.f, 0.f, 0.f};
        DSA_LAS unsigned char* vimg = (DSA_LAS unsigned char*)(lds + LDS_SC) + wid * (SC_STRIDE * 4);
#pragma unroll
        for (int hf = 0; hf < 2; ++hf) {
            if (hf == 1) asm volatile("s_waitcnt lgkmcnt(0)" ::: "memory");
#pragma unroll
            for (int i = 0; i < 16; ++i) { const int slot = 8 * i + (lane >> 3), gslot = 128 * hf + slot, ch = lane & 7;
                int kid = myidx[gslot]; if (gslot >= cntq) kid = 0;
                const u32x4 val = *(const u32x4*)(P + (size_t)(rowbase + kid) * PA + VOFF + ch * 8);
                *(DSA_LAS u32x4*)(vimg + slot * 128 + ((ch ^ (((slot >> 1) & 3) << 1)) * 16)) = val; }
            asm volatile("s_waitcnt vmcnt(0) lgkmcnt(0)" ::: "memory");
#pragma unroll
            for (int ksl = 0; ksl < 4; ++ksl) {
                const int ks = 4 * hf + ksl;
                u32x4 pw; pw.x = cvtpk(st[2 * ks][0], st[2 * ks][1]); pw.y = cvtpk(st[2 * ks][2], st[2 * ks][3]); pw.z = cvtpk(st[2 * ks + 1][0], st[2 * ks + 1][1]); pw.w = cvtpk(st[2 * ks + 1][2], st[2 * ks + 1][3]);
                const bf16x8 PF = __builtin_bit_cast(bf16x8, pw);
                const int q_ = c16 >> 2, p_ = lane & 3, r1 = 32 * ksl + 4 * g4 + q_, r2 = r1 + 16;
#pragma unroll
                for (int nd = 0; nd < 4; ++nd) {
                    const int chunk = 2 * nd + (p_ >> 1);
                    const s16x4 vlo = trrd(vimg + r1 * 128 + ((chunk ^ (((r1 >> 1) & 3) << 1)) * 16) + (p_ & 1) * 8);
                    const s16x4 vhi = trrd(vimg + r2 * 128 + ((chunk ^ (((r2 >> 1) & 3) << 1)) * 16) + (p_ & 1) * 8);
                    const bf16x8 VF = (bf16x8){vlo[0], vlo[1], vlo[2], vlo[3], vhi[0], vhi[1], vhi[2], vhi[3]};
                    o[nd] = __builtin_amdgcn_mfma_f32_16x16x32_bf16(PF, VF, o[nd], 0, 0, 0);
                }
            }
        }
        const float linv = 1.0f / lsum;
        bf16_t* op = O + (size_t)(rowbase + t) * 1024;
#pragma unroll
        for (int r = 0; r < 4; ++r) { const int hh = 4 * g4 + r; const float lv = __shfl(linv, hh);
#pragma unroll
            for (int nd = 0; nd < 4; ++nd) { const unsigned pk = cvtpk(o[nd][r] * lv, 0.f); op[hh * 64 + 16 * nd + c16] = (bf16_t)(pk & 0xffffu); } }
    }
    __syncthreads();
}

__device__ __forceinline__ void dsa_phase(DSA_LAS unsigned char* lds, const bf16_t* P, const float* WI, bf16_t* O, int vcu, int G, int wid, int lane) {
    for (int i = 0;; ++i) {
        int b, u;
        if (G == 256) { if (i >= 16) break; const int k = 15 - i, r = vcu & 31; b = vcu >> 5; u = 32 * k + ((k & 1) ? (31 - r) : r); }
        else { const int ug = vcu + i * G; if (ug >= 8 * 512) break; b = ug >> 9; u = ug & 511; }
        dsa_unit(lds, P, WI, O, b, 8 * u, wid, lane);
    }
}
#undef DSA_LAS
}

constexpr int NWAVES = 8;
constexpr int NB = 8, SEQ = 4096, D = 1024, FF = 2752, FFP = 2816, NGU = 5632, DEPTH = 4;
constexpr int M = NB * SEQ;
constexpr int A_IN = 1736, A_INP = 1792, B_IN = 3072;
constexpr float EPS = 1e-6f;
constexpr float QSCALE = 0.125f * 1.4426950408889634f;
constexpr float WISCALE = 0.04419417382415922f;
constexpr size_t MiB = 1u << 20;
constexpr size_t WS_CTL = 0, CTL_ZERO_BYTES = 1 * MiB;
constexpr size_t WS_MOD = 2 * MiB;
constexpr size_t WS_ROPE = 4 * MiB;
constexpr size_t WS_WI = 6 * MiB;
constexpr size_t WS_W = 8 * MiB;
constexpr size_t W_FFN_STRIDE = 17301504, W_D_OFF = 11534336;
constexpr size_t W_DSA = WS_W + 8 * W_FFN_STRIDE, W_DSA_STRIDE = 5767168, W_DSA_OUT_OFF = 3670016;
constexpr size_t W_DIFF = W_DSA + 2 * W_DSA_STRIDE, W_DIFF_STRIDE = 8 * MiB, W_DIFF_OUT_OFF = 6 * MiB;
constexpr size_t WS_H = 168 * MiB;
constexpr size_t WS_Y = 232 * MiB;
constexpr size_t WS_BIG = 296 * MiB;
constexpr size_t WS_END = 488 * MiB;
static_assert(W_DIFF + 2 * W_DIFF_STRIDE <= WS_H && WS_Y == WS_H + 64 * MiB && WS_BIG == WS_Y + 64 * MiB && WS_BIG + (size_t)M * B_IN * 2 <= WS_END, "d_ws map");
constexpr int CW_BAR = 4096;
constexpr int RING_OFF = 0, RING_BYTES = 131072;
constexpr int IDX_OFF = RING_BYTES;
constexpr int LDSCTL_OFF = RING_BYTES + 4096, MISC_OFF = LDSCTL_OFF + 320;
constexpr int LDS_BYTES = 147456;
static_assert(MISC_OFF + 128 <= LDS_BYTES && dsa::LDS_IDX == IDX_OFF, "LDS map");

__device__ __forceinline__ float wave_sum(float v) {
#pragma unroll
    for (int o = 1; o < 64; o <<= 1) v += __shfl_xor(v, o);
    return v;
}
__device__ __forceinline__ int rope_perm16(int p) { return (p < 8) ? ((p & 1) ? 8 + (p >> 1) : (p >> 1)) : ((p & 1) ? 12 + ((p - 8) >> 1) : 4 + ((p - 8) >> 1)); }
__device__ __forceinline__ void tr_item(const float* W, int ldw, int Ksrc, int ncols, bf16* WT, int ldt, int k0, int d0, int col0, bool perm, LAS float* scr, int lane) {
    const int dl = lane & 31;
    int col = -1;
    if (col0 >= 0) { col = col0 + ((perm && dl < 16) ? rope_perm16(dl) : dl); if (col >= ncols) col = -1; }
#pragma unroll 8
    for (int i = 0; i < 32; ++i) { const int kk = 2 * i + (lane >> 5), k = k0 + kk; float v = 0.f; if (col >= 0 && k < Ksrc) v = W[(size_t)k * ldw + col]; scr[kk * 33 + dl] = v; }
    LDS_WAIT(); asm volatile("" ::: "memory");
    const int c = lane & 7;
#pragma unroll
    for (int j = 0; j < 4; ++j) { const int n = (lane >> 3) + 8 * j; const LAS float* s = scr + (8 * c) * 33 + n;
        v4u o; o.x = pk2(s[0 * 33], s[1 * 33]); o.y = pk2(s[2 * 33], s[3 * 33]); o.z = pk2(s[4 * 33], s[5 * 33]); o.w = pk2(s[6 * 33], s[7 * 33]);
        *(GAS v4u*)(WT + (size_t)(d0 + n) * ldt + k0 + 8 * c) = o; }
    LDS_WAIT(); asm volatile("" ::: "memory");
}

struct Args { const float* in[16]; float* out; unsigned char* ws; };

typedef const __attribute__((address_space(4))) Args* kargs_t0;
__device__ __forceinline__ void p0_prologue(kargs_t0 ap, LAS unsigned char* lds, int tid, int lane, int wave, int vcu, int G) {
    unsigned char* ws = ap->ws;
    if (vcu < 144) {
        LAS float* cond = (LAS float*)lds;
        LAS float* red = (LAS float*)(lds + 32768);
        const float* cin = ap->in[1];
        for (int i = tid; i < 8 * 1024; i += NWAVES * 64) { const float x = cin[i]; cond[i] = x / (1.0f + __expf(-x)); }
        __syncthreads();
        const int l = vcu / 36, n0 = (vcu % 36) * 256;
        const float* Wl = ap->in[3] + (size_t)l * 1024 * 9216 + n0 + 4 * lane;
        f32x4 acc[8];
#pragma unroll
        for (int b = 0; b < 8; ++b) acc[b] = (f32x4){0.f, 0.f, 0.f, 0.f};
#pragma unroll 4
        for (int kk = 0; kk < 128; ++kk) { const int k = 128 * wave + kk; const f32x4 wv = *(const f32x4*)(Wl + (size_t)k * 9216);
#pragma unroll
            for (int b = 0; b < 8; ++b) acc[b] += wv * cond[b * 1024 + k]; }
#pragma unroll
        for (int b = 0; b < 8; ++b) *(LAS f32x4*)(red + (wave * 8 + b) * 256 + 4 * lane) = acc[b];
        __syncthreads();
        { const int o = tid * 4, b = o >> 8, col = o & 255; f32x4 s = *(const f32x4*)(ap->in[4] + (size_t)l * 9216 + n0 + col);
#pragma unroll
          for (int w = 0; w < 8; ++w) s += *(LAS f32x4*)(red + (w * 8 + b) * 256 + col);
          *(f32x4*)((float*)(ws + WS_MOD) + ((size_t)l * 8 + b) * 9216 + n0 + col) = s; }
        __syncthreads();
    }
    { const int* pos = (const int*)ap->in[2]; float* tab = (float*)(ws + WS_ROPE);
      for (int i = vcu * (NWAVES * 64) + tid; i < M * 8; i += G * NWAVES * 64) { const int row = i >> 3, j = i & 7;
          const float inv = (j == 0) ? 1.0f : (j == 1) ? 0.19392274474868576f : (j == 2) ? 0.03760603093086393f : (j == 3) ? 0.007292664737217109f : (j == 4) ? 0.001414213562373095f : (j == 5) ? 0.0002742481756762073f : (j == 6) ? 5.318295896944988e-05f : 1.031338537721246e-05f;
          const float ang = (float)pos[row] * inv;
          const double rev = (double)ang * 0.15915494309189535; const float fr = (float)(rev - __builtin_rint(rev));
          tab[(size_t)row * 16 + j] = __builtin_amdgcn_cosf(fr); tab[(size_t)row * 16 + 8 + j] = __builtin_amdgcn_sinf(fr); } }
    LAS float* scr = (LAS float*)(lds + wave * 16384);
    const int gw = vcu * NWAVES + wave, NGW = G * NWAVES;
    constexpr int I_GU = 16 * 176, I_D = 44 * 32, I_FFN = I_GU + I_D, I_AIN = 16 * 56, I_O = 16 * 32, I_DSA = I_AIN + I_O, I_BIN = 16 * 96, I_DIFF = I_BIN + I_O;
    constexpr int NITEMS = 8 * I_FFN + 2 * I_DSA + 2 * I_DIFF;
    for (int it = gw; it < NITEMS; it += NGW) {
        int r = it;
        if (r < 8 * I_FFN) { const int f = r / I_FFN; r -= f * I_FFN;
            if (r < I_GU) { const int kb = r / 176, nb = r % 176, d0 = 32 * nb, p = d0 >> 8, w0 = d0 & 255; const bool up = w0 >= 128;
                const float* W = (up ? ap->in[8] : ap->in[7]) + (size_t)f * 1024 * FF;
                tr_item(W, FF, 1024, FF, (bf16*)(ws + WS_W + f * W_FFN_STRIDE), 1024, 64 * kb, d0, 128 * p + (w0 & 127), false, scr, lane); }
            else { r -= I_GU; const int kb = r / 32, nb = r % 32;
                tr_item(ap->in[9] + (size_t)f * FF * 1024, 1024, FF, 1024, (bf16*)(ws + WS_W + f * W_FFN_STRIDE + W_D_OFF), FFP, 64 * kb, 32 * nb, 32 * nb, false, scr, lane); }
            continue; }
        r -= 8 * I_FFN;
        if (r < 2 * I_DSA) { const int j = r / I_DSA; r -= j * I_DSA;
            if (r < I_AIN) { const int kb = r / 56, nb = r % 56, d0 = 32 * nb; const bool perm = (d0 < 1728) && !(d0 >= 1088 && d0 < 1152) && ((d0 & 63) == 0);
                tr_item(ap->in[10] + (size_t)j * 1024 * A_IN, A_IN, 1024, A_IN, (bf16*)(ws + W_DSA + j * W_DSA_STRIDE), 1024, 64 * kb, d0, d0, perm, scr, lane); }
            else { r -= I_AIN; const int kb = r / 32, nb = r % 32;
                tr_item(ap->in[11] + (size_t)j * 1024 * 1024, 1024, 1024, 1024, (bf16*)(ws + W_DSA + j * W_DSA_STRIDE + W_DSA_OUT_OFF), 1024, 64 * kb, 32 * nb, 32 * nb, false, scr, lane); }
            continue; }
        r -= 2 * I_DSA;
        { const int j = r / I_DIFF; r -= j * I_DIFF;
            if (r < I_BIN) { const int kb = r / 96, nb = r % 96, d0 = 32 * nb; const bool perm = (d0 < 2048) && ((d0 & 63) == 0);
                tr_item(ap->in[12] + (size_t)j * 1024 * B_IN, B_IN, 1024, B_IN, (bf16*)(ws + W_DIFF + j * W_DIFF_STRIDE), 1024, 64 * kb, d0, d0, perm, scr, lane); }
            else { r -= I_BIN; const int kb = r / 32, nb = r % 32;
                tr_item(ap->in[13] + (size_t)j * 1024 * 1024, 1024, 1024, 1024, (bf16*)(ws + W_DIFF + j * W_DIFF_STRIDE + W_DIFF_OUT_OFF), 1024, 64 * kb, 32 * nb, 32 * nb, false, scr, lane); }
        }
    }
}

template <bool HAS_Y, bool HAS_H>
__device__ __forceinline__ void thin_phase(int gw, int NGW, int lane, const bf16* Y, const float* XIN, float* XOUT, bf16* HOUT,
                                           const float* gate, const float* pn, float coef, const float* pre, const float* sc, const float* sh, bool poison) {
    typedef unsigned u32x2 __attribute__((ext_vector_type(2)));
    for (int ch = gw; ch < M / 16; ch += NGW) {
        const int b = ch >> 8;
        f32x4 a1[4], a2[4], a3[4];
#pragma unroll
        for (int j = 0; j < 4; ++j) { const int col = 4 * lane + 256 * j;
            if (HAS_Y) a1[j] = *(const f32x4*)(gate + (size_t)b * 9216 + col) * *(const f32x4*)(pn + col) * coef;
            if (HAS_H) { a2[j] = *(const f32x4*)(pre + col) * (*(const f32x4*)(sc + (size_t)b * 9216 + col) + 1.0f); a3[j] = *(const f32x4*)(sh + (size_t)b * 9216 + col); } }
#pragma unroll 2
        for (int r = 0; r < 16; ++r) { const size_t row = (size_t)ch * 16 + r;
            f32x4 xv[4];
#pragma unroll
            for (int j = 0; j < 4; ++j) xv[j] = *(const f32x4*)(XIN + row * D + 4 * lane + 256 * j);
            if (HAS_Y) { f32x4 yv[4]; float ss = 0.f;
#pragma unroll
                for (int j = 0; j < 4; ++j) { const u32x2 q = *(const u32x2*)(Y + row * D + 4 * lane + 256 * j);
                    yv[j] = (f32x4){__builtin_bit_cast(float, q.x << 16), __builtin_bit_cast(float, q.x & 0xffff0000u), __builtin_bit_cast(float, q.y << 16), __builtin_bit_cast(float, q.y & 0xffff0000u)};
                    ss += (yv[j].x * yv[j].x + yv[j].y * yv[j].y) + (yv[j].z * yv[j].z + yv[j].w * yv[j].w); }
                const float rs = 1.0f / sqrtf(wave_sum(ss) * (1.0f / D) + EPS);
                const float qn = __builtin_nanf("");
#pragma unroll
                for (int j = 0; j < 4; ++j) { xv[j] = xv[j] + a1[j] * yv[j] * rs; *(f32x4*)(XOUT + row * D + 4 * lane + 256 * j) = poison ? (f32x4){qn, qn, qn, qn} : xv[j]; } }
            if (HAS_H) { float s2 = 0.f;
#pragma unroll
                for (int j = 0; j < 4; ++j) s2 += (xv[j].x * xv[j].x + xv[j].y * xv[j].y) + (xv[j].z * xv[j].z + xv[j].w * xv[j].w);
                const float r2 = 1.0f / sqrtf(wave_sum(s2) * (1.0f / D) + EPS);
#pragma unroll
                for (int j = 0; j < 4; ++j) { const f32x4 hv = xv[j] * r2 * a2[j] + a3[j]; u32x2 o; o.x = pk2(hv.x, hv.y); o.y = pk2(hv.z, hv.w); *(u32x2*)(HOUT + row * D + 4 * lane + 256 * j) = o; } }
        }
    }
}

__device__ __forceinline__ void diff_combine(int gw, int NGW, int lane, const bf16* O, bf16* OUT, const float* lam, const float* subln, int layer_idx) {
    const float s01 = wave_sum(lam[lane] * lam[64 + lane]), s23 = wave_sum(lam[128 + lane] * lam[192 + lane]);
    const float lam_init = 0.8f - 0.6f * __expf(-0.3f * (float)layer_idx), lam_val = __expf(s01) - __expf(s23) + lam_init;
    const int head = lane >> 3, e0 = (lane & 7) * 16;
    float gs[16];
#pragma unroll
    for (int i = 0; i < 16; ++i) gs[i] = subln[e0 + i] * (1.0f - lam_init);
    for (int row = gw; row < M; row += NGW) {
        const bf16* p0 = O + (size_t)row * 2048 + head * 128 + e0; const bf16* p1 = p0 + 1024;
        const v4u a0 = *(const v4u*)p0, a1 = *(const v4u*)(p0 + 8), b0 = *(const v4u*)p1, b1 = *(const v4u*)(p1 + 8);
        float d[16]; float ss = 0.f;
#pragma unroll
        for (int i = 0; i < 4; ++i) { const unsigned ua = a0[i], ub = b0[i], uc = a1[i], ud = b1[i];
            d[2 * i] = __builtin_bit_cast(float, ua << 16) - lam_val * __builtin_bit_cast(float, ub << 16); d[2 * i + 1] = __builtin_bit_cast(float, ua & 0xffff0000u) - lam_val * __builtin_bit_cast(float, ub & 0xffff0000u);
            d[8 + 2 * i] = __builtin_bit_cast(float, uc << 16) - lam_val * __builtin_bit_cast(float, ud << 16); d[8 + 2 * i + 1] = __builtin_bit_cast(float, uc & 0xffff0000u) - lam_val * __builtin_bit_cast(float, ud & 0xffff0000u); }
#pragma unroll
        for (int i = 0; i < 16; ++i) ss += d[i] * d[i];
        ss += __shfl_xor(ss, 1); ss += __shfl_xor(ss, 2); ss += __shfl_xor(ss, 4);
        const float rs = 1.0f / sqrtf(ss * (1.0f / 128.0f) + EPS);
        v4u o0, o1;
#pragma unroll
        for (int i = 0; i < 4; ++i) { o0[i] = pk2(d[2 * i] * rs * gs[2 * i], d[2 * i + 1] * rs * gs[2 * i + 1]); o1[i] = pk2(d[8 + 2 * i] * rs * gs[8 + 2 * i], d[8 + 2 * i + 1] * rs * gs[8 + 2 * i + 1]); }
        bf16* q = OUT + (size_t)row * 1024 + head * 128 + e0; *(v4u*)q = o0; *(v4u*)(q + 8) = o1;
    }
}

typedef const __attribute__((address_space(4))) Args* kargs_t;
__device__ __forceinline__ kargs_t kargs_ptr() { kargs_t p = (kargs_t)__builtin_amdgcn_kernarg_segment_ptr(); asm volatile("" : "+s"(p)); return p; }
#define KARGS() const kargs_t A_ = kargs_ptr(); unsigned char* const ws = A_->ws; (void)ws
#define GRID_BAR() do { XcdBarrier bar_; { KARGS(); bar_.bar = (unsigned*)(ws + WS_CTL) + CW_BAR; } bar_.x = xb_xcc_id(); bar_.st = (volatile LAS unsigned*)(lds + MISC_OFF) + 8; xcd_barrier(bar_); } while (0)
#define VCU_G() int G_l = gridDim.x, bx_l = blockIdx.x; asm volatile("" : "+s"(G_l), "+s"(bx_l)); const int G = G_l; const int vcu = (G % 8 == 0) ? (bx_l % 8) * (G / 8) + bx_l / 8 : bx_l; (void)vcu
#define WAVE_IDS() int tid_l = threadIdx.x; asm volatile("" : "+v"(tid_l)); const int tid = tid_l, lane = tid & 63, wave = __builtin_amdgcn_readfirstlane(tid >> 6); (void)lane; (void)wave

__device__ __forceinline__ void ffn_block(LAS unsigned char* lds, int L, int S, bool first) {
    const int f_ = L * 2 + S;
    { KARGS(); VCU_G(); pg8::Gemm g{(const bf16*)(ws + WS_H), (const bf16*)(ws + WS_W + f_ * W_FFN_STRIDE), M, NGU, D}; pg8::StaticOrder So; So.init(M, NGU, G, bx_l);
      pg8::EpiSwiGLU E{(bf16*)(ws + WS_BIG), FFP}; pg8::gemm_phase<pg8::EpiSwiGLU, pg8::StaticOrder, true, true>(lds + RING_OFF, g, So, E); }
    GRID_BAR();
    { KARGS(); VCU_G(); pg8::Gemm g{(const bf16*)(ws + WS_BIG), (const bf16*)(ws + WS_W + f_ * W_FFN_STRIDE + W_D_OFF), M, D, FFP}; pg8::StaticOrder So; So.init(M, D, G, bx_l);
      pg8::EpiBf16<0> E{(bf16*)(ws + WS_Y), D}; pg8::gemm_phase<pg8::EpiBf16<0>, pg8::StaticOrder, true, true>(lds + RING_OFF, g, So, E); }
    GRID_BAR();
    { KARGS(); VCU_G(); WAVE_IDS(); const int gw = vcu * NWAVES + wave, NGW = G * NWAVES;
      const int k_ = S ? 2 : 0; const int ln_ = S ? L + 1 : L, kn_ = S ? 0 : 1;
      const float* mod = (const float*)(ws + WS_MOD); const float* pre_norm = A_->in[5]; const float* post_norm = A_->in[6];
      const float* xin = first ? A_->in[0] : (const float*)A_->out;
      const bool poison_ = (__hip_atomic_load((gu32*)(ws + WS_CTL) + CW_BAR + XB_TMO, RLX_AGENT) != 0u);
      if (ln_ < DEPTH) thin_phase<true, true>(gw, NGW, lane, (const bf16*)(ws + WS_Y), xin, A_->out, (bf16*)(ws + WS_H), mod + (size_t)L * 73728 + (3 * k_ + 2) * 1024, post_norm + (L * 3 + k_) * 1024, 0.5f,
                            pre_norm + (ln_ * 3 + kn_) * 1024, mod + (size_t)ln_ * 73728 + (3 * kn_ + 1) * 1024, mod + (size_t)ln_ * 73728 + (3 * kn_) * 1024, poison_);
      else thin_phase<true, false>(gw, NGW, lane, (const bf16*)(ws + WS_Y), xin, A_->out, nullptr, mod + (size_t)L * 73728 + (3 * k_ + 2) * 1024, post_norm + (L * 3 + k_) * 1024, 0.5f, nullptr, nullptr, nullptr, poison_); }
    GRID_BAR();
}
__device__ __forceinline__ void mix_tail(LAS unsigned char* lds, int L, size_t a_off, size_t w_off) {
    { KARGS(); VCU_G(); pg8::Gemm g{(const bf16*)(ws + a_off), (const bf16*)(ws + w_off), M, D, D}; pg8::StaticOrder So; So.init(M, D, G, bx_l);
      pg8::EpiBf16<0> E{(bf16*)(ws + WS_Y), D}; pg8::gemm_phase<pg8::EpiBf16<0>, pg8::StaticOrder, true, true>(lds + RING_OFF, g, So, E); }
    GRID_BAR();
    { KARGS(); VCU_G(); WAVE_IDS(); const int gw = vcu * NWAVES + wave, NGW = G * NWAVES;
      const float* mod = (const float*)(ws + WS_MOD); const float* pre_norm = A_->in[5]; const float* post_norm = A_->in[6];
      thin_phase<true, true>(gw, NGW, lane, (const bf16*)(ws + WS_Y), (const float*)A_->out, A_->out, (bf16*)(ws + WS_H), mod + (size_t)L * 73728 + 5 * 1024, post_norm + (L * 3 + 1) * 1024, 1.0f,
                             pre_norm + (L * 3 + 2) * 1024, mod + (size_t)L * 73728 + 7 * 1024, mod + (size_t)L * 73728 + 6 * 1024, false); }
    GRID_BAR();
}

__global__ void __launch_bounds__(NWAVES * 64, 2) hybrid_fwd(Args args) {
    extern __shared__ __attribute__((aligned(16))) unsigned char lds_raw[];
    LAS unsigned char* lds = (LAS unsigned char*)lds_raw;
    { WAVE_IDS(); for (int u = tid; u < (LDS_BYTES - LDSCTL_OFF) / 4; u += NWAVES * 64) ((LAS unsigned*)(lds + LDSCTL_OFF))[u] = 0u; }
    __syncthreads();
    { KARGS(); (void)xcd_barrier_post((unsigned*)(ws + WS_CTL) + CW_BAR, (volatile LAS unsigned*)(lds + MISC_OFF) + 8); }

    { KARGS(); VCU_G(); WAVE_IDS(); p0_prologue(A_, lds, tid, lane, wave, vcu, G); }
    GRID_BAR();
    { KARGS(); VCU_G(); WAVE_IDS(); const float* mod = (const float*)(ws + WS_MOD);
      thin_phase<false, true>(vcu * NWAVES + wave, G * NWAVES, lane, nullptr, A_->in[0], nullptr, (bf16*)(ws + WS_H), nullptr, nullptr, 0.f, A_->in[5], mod + 1024, mod, false); }
    GRID_BAR();

    for (int j = 0; j < 2; ++j) {
        const int la = 2 * j, lb = 2 * j + 1;
        ffn_block(lds, la, 0, j == 0);
        { KARGS(); VCU_G(); pg8::Gemm g{(const bf16*)(ws + WS_H), (const bf16*)(ws + W_DSA + j * W_DSA_STRIDE), M, A_INP, D}; pg8::StaticOrder So; So.init(M, A_INP, G, bx_l);
          pg8::EpiProj E{(bf16*)(ws + WS_BIG), A_INP, (const float*)(ws + WS_ROPE), 1728, 1088, 1152, 1024, QSCALE, (float*)(ws + WS_WI), 1728, WISCALE};
          pg8::gemm_phase<pg8::EpiProj, pg8::StaticOrder, true, true>(lds + RING_OFF, g, So, E); }
        GRID_BAR();
        { KARGS(); VCU_G(); WAVE_IDS(); dsa::dsa_phase(lds, (const bf16*)(ws + WS_BIG), (const float*)(ws + WS_WI), (bf16*)(ws + WS_H), vcu, G, wave, lane); }
        GRID_BAR();
        mix_tail(lds, la, WS_H, W_DSA + j * W_DSA_STRIDE + W_DSA_OUT_OFF);
        ffn_block(lds, la, 1, false);
        ffn_block(lds, lb, 0, false);
        { KARGS(); VCU_G(); pg8::Gemm g{(const bf16*)(ws + WS_H), (const bf16*)(ws + W_DIFF + j * W_DIFF_STRIDE), M, B_IN, D}; pg8::StaticOrder So; So.init(M, B_IN, G, bx_l);
          pg8::EpiProj E{(bf16*)(ws + WS_BIG), B_IN, (const float*)(ws + WS_ROPE), 2048, 0, 0, 1024, QSCALE, nullptr, -1, 0.f};
          pg8::gemm_phase<pg8::EpiProj, pg8::StaticOrder, true, true>(lds + RING_OFF, g, So, E); }
        GRID_BAR();
        { KARGS(); VCU_G(); const attn_body::bf16* P = (const attn_body::bf16*)(ws + WS_BIG);
          const attn_body::AttnTensors AT{P, P + 1024, P + 2048, (attn_body::bf16*)(ws + WS_H)};
          attn_body::attn_phase<8>((char*)lds_raw + RING_OFF, AT, vcu, G); }
        GRID_BAR();
        { KARGS(); VCU_G(); WAVE_IDS(); diff_combine(vcu * NWAVES + wave, G * NWAVES, lane, (const bf16*)(ws + WS_H), (bf16*)(ws + WS_BIG), A_->in[14] + j * 256, A_->in[15] + j * 128, lb); }
        GRID_BAR();
        mix_tail(lds, lb, WS_BIG, W_DIFF + j * W_DIFF_STRIDE + W_DIFF_OUT_OFF);
        ffn_block(lds, lb, 1, false);
    }
}

extern "C" void kernel_launch(void* const* d_in, const int* in_sizes, int n_in, void* d_out, int out_size, void* d_ws, size_t ws_size, hipStream_t stream) {
    static int grid = 0;
    if (grid == 0) {
        if (n_in != 16 || out_size != M * D || ws_size < WS_END) { fprintf(stderr, "kernel_launch: unexpected shapes (n_in %d, out %d, ws %zu); nothing launched\n", n_in, out_size, ws_size); grid = -1; return; }
        int dev = 0, cus = 0, per_cu = 0;
        if (hipGetDevice(&dev) != hipSuccess || hipDeviceGetAttribute(&cus, hipDeviceAttributeMultiprocessorCount, dev) != hipSuccess) { grid = -1; return; }
        if (hipFuncSetAttribute((const void*)hybrid_fwd, hipFuncAttributeMaxDynamicSharedMemorySize, LDS_BYTES) != hipSuccess) { fprintf(stderr, "kernel_launch: hipFuncSetAttribute failed\n"); grid = -1; return; }
        if (hipOccupancyMaxActiveBlocksPerMultiprocessor(&per_cu, (const void*)hybrid_fwd, NWAVES * 64, LDS_BYTES) != hipSuccess || per_cu < 1) { fprintf(stderr, "kernel_launch: occupancy query reports %d\n", per_cu); }
        (void)hipGetLastError();
        grid = cus;
    }
    if (grid < 0) return;
    if (hipMemsetAsync((char*)d_ws + WS_CTL, 0, CTL_ZERO_BYTES, stream) != hipSuccess) return;
    Args a{};
    for (int i = 0; i < 16; ++i) a.in[i] = (const float*)d_in[i];
    a.out = (float*)d_out; a.ws = (unsigned char*)d_ws;
    hipLaunchKernelGGL(hybrid_fwd, dim3(grid), dim3(NWAVES * 64), LDS_BYTES, stream, a);
}
```

```cpp
#include <hip/hip_runtime.h>
#include <hip/hip_bf16.h>
#include <cstdio>
#include <cstdint>
#include <cmath>
namespace pg8 {
#define PG8_LAS __attribute__((address_space(3)))
typedef unsigned short bf16_t;
typedef short bf16x8 __attribute__((ext_vector_type(8)));
typedef float f32x4 __attribute__((ext_vector_type(4)));
typedef unsigned u32x4 __attribute__((ext_vector_type(4)));
constexpr size_t SLAB_EL = 4194304;
constexpr int BM = 256, BK = 64, HALF = 128, HTB = HALF * BK * 2  , STAGE_BYTES = 8 * HTB, NXCD = 8, WGM = 8;

__host__ __device__ __forceinline__ int lds_byte(int r, int c) { const int st = (r >> 4) * 2 + (c >> 5), rr = r & 15, cc = c & 31, ob = rr * 64 + cc * 2; return st * 1024 + (ob ^ (((ob >> 9) & 1) << 5)); }
__host__ __device__ __forceinline__ void stage_rc(int b, int& R, int& C) { const int st = b / 1024, sb = b % 1024, swz = sb ^ (((sb >> 9) & 1) << 5); R = (st >> 1) * 16 + swz / 64; C = (st & 1) * 32 + (swz % 64) / 2; }
__host__ __device__ __forceinline__ int perm32(int rho) { const int n = rho >> 4, i = rho & 15; return 8 * (i >> 2) + 4 * n + (i & 3); }

struct Unit { int pm, pn; };
struct Gemm { const bf16_t* A; const bf16_t* Bt; int M, N, K, lda; };

struct StaticOrder {
    int nM, nN, nwg, G, c;
    __host__ __device__ void init(int M, int N, int G_, int c_) { nM = M / BM; nN = N / BM; nwg = nM * nN; G = G_; c = c_; }
    __host__ __device__ bool next(int i, Unit& u) const {
        const long L = (long)i * G + c; if (L >= nwg) return false;
        int wgid = (int)L; { const int q = nwg / NXCD, r = nwg % NXCD, xcd = wgid % NXCD, off = wgid / NXCD; wgid = (xcd < r ? xcd * (q + 1) : r * (q + 1) + (xcd - r) * q) + off; }
        const int nig = WGM * nN, gid = wgid / nig, fm = gid * WGM, gsz = (nM - fm) < WGM ? (nM - fm) : WGM;
        u.pm = fm + ((wgid % nig) % gsz); u.pn = (wgid % nig) / gsz; return true;
    }
    __device__ __forceinline__ void a_ready(const Unit&) const {}
    __device__ __forceinline__ void done(const Unit&) const {}
};

__device__ __forceinline__ unsigned cvt_pk_bf16(float lo, float hi) { unsigned r; asm volatile("v_cvt_pk_bf16_f32 %0, %1, %2" : "=v"(r) : "v"(lo), "v"(hi)); return r; }
typedef float f32x2 __attribute__((ext_vector_type(2)));
template <int ACT> struct EpiBf16 {
    static constexpr bool PERM = true, AFTER_DRAIN = false;
    bf16_t* O; int ldc;
    __device__ __forceinline__ void operator()(const f32x4 (&acc)[2][2][4][2], const Unit& u, int wr, int wc, int fr, int fq) const {
        const int row0 = u.pm * BM + wr * 64 + fr; const int col0 = u.pn * BM + wc * 32 + 8 * fq;
#pragma unroll
        for (int ai = 0; ai < 2; ++ai)
#pragma unroll
            for (int m = 0; m < 4; ++m) { bf16_t* rowp = O + (size_t)(row0 + ai * HALF + m * 16) * ldc + col0;
#pragma unroll
                for (int bj = 0; bj < 2; ++bj) { const f32x4 v0 = acc[ai][bj][m][0], v1 = acc[ai][bj][m][1];
                    u32x4 w; w.x = cvt_pk_bf16(v0[0], v0[1]); w.y = cvt_pk_bf16(v0[2], v0[3]); w.z = cvt_pk_bf16(v1[0], v1[1]); w.w = cvt_pk_bf16(v1[2], v1[3]);
                    *(u32x4*)(rowp + bj * HALF) = w; } }
    }
};

__device__ __forceinline__ unsigned pk4_fp8(float a, float b, float c, float d) { a = __builtin_amdgcn_fmed3f(a, -448.0f, 448.0f); b = __builtin_amdgcn_fmed3f(b, -448.0f, 448.0f); c = __builtin_amdgcn_fmed3f(c, -448.0f, 448.0f); d = __builtin_amdgcn_fmed3f(d, -448.0f, 448.0f);
    int o = 0; o = __builtin_amdgcn_cvt_pk_fp8_f32(a, b, o, false); o = __builtin_amdgcn_cvt_pk_fp8_f32(c, d, o, true); return (unsigned)o; }
template <bool O8> struct EpiSwiGLU {
    static constexpr bool PERM = true, AFTER_DRAIN = false;
    bf16_t* O; int ldc;
    __device__ __forceinline__ static float sg(float g, float u) { const float e = __builtin_amdgcn_exp2f(g * -1.4426950408889634f); return g * u * __builtin_amdgcn_rcpf(1.0f + e); }
    __device__ __forceinline__ void operator()(const f32x4 (&acc)[2][2][4][2], const Unit& u, int wr, int wc, int fr, int fq) const {
        const int row0 = u.pm * BM + wr * 64 + fr; const int col0 = u.pn * HALF + wc * 32 + 8 * fq;
#pragma unroll
        for (int ai = 0; ai < 2; ++ai)
#pragma unroll
            for (int m = 0; m < 4; ++m) { bf16_t* rowp = O + (size_t)(row0 + ai * HALF + m * 16) * ldc + col0;
                const f32x4 g0 = acc[ai][0][m][0], g1 = acc[ai][0][m][1], u0 = acc[ai][1][m][0], u1 = acc[ai][1][m][1];
                if constexpr (O8) { typedef unsigned v2u_ __attribute__((ext_vector_type(2))); v2u_ w;
#define SG2(GV, UV, I) ({ const f32x2 g_ = {GV[I], GV[I + 1]}, u_ = {UV[I], UV[I + 1]}; const f32x2 t_ = g_ * -1.4426950408889634f; f32x2 e_; e_.x = __builtin_amdgcn_exp2f(t_.x); e_.y = __builtin_amdgcn_exp2f(t_.y); \
                          const f32x2 d_ = e_ + 1.0f; f32x2 r_; r_.x = __builtin_amdgcn_rcpf(d_.x); r_.y = __builtin_amdgcn_rcpf(d_.y); (g_ * (u_ * 16.0f)) * r_; })
                    { const f32x2 a_ = SG2(g0, u0, 0), b_ = SG2(g0, u0, 2), c_ = SG2(g1, u1, 0), d2_ = SG2(g1, u1, 2); w.x = pk4_fp8(a_.x, a_.y, b_.x, b_.y); w.y = pk4_fp8(c_.x, c_.y, d2_.x, d2_.y); }
#undef SG2
                    *(v2u_*)((unsigned char*)(O + (size_t)(row0 + ai * HALF + m * 16) * ldc) + col0) = w; }
                else { u32x4 w; w.x = cvt_pk_bf16(sg(g0[0], u0[0]), sg(g0[1], u0[1])); w.y = cvt_pk_bf16(sg(g0[2], u0[2]), sg(g0[3], u0[3]));
                w.z = cvt_pk_bf16(sg(g1[0], u1[0]), sg(g1[1], u1[1])); w.w = cvt_pk_bf16(sg(g1[2], u1[2]), sg(g1[3], u1[3]));
                *(u32x4*)rowp = w; } }
    }
};

struct EpiProj {
    static constexpr bool PERM = true, AFTER_DRAIN = false;
    bf16_t* O; int ldc; const float* rope; int rope_end, nr_lo, nr_hi, qs_end; float qscale; float* wi; int wi_col; float wscale;
    bf16_t* kit; int ki_lo;
    bf16_t* kv; int kv_lo;
    __device__ __forceinline__ void operator()(const f32x4 (&acc)[2][2][4][2], const Unit& u, int wr, int wc, int fr, int fq) const {
        const int row0 = u.pm * BM + wr * 64 + fr;
#pragma unroll
        for (int bj = 0; bj < 2; ++bj) {
            const int c8 = u.pn * BM + bj * HALF + wc * 32 + 8 * fq;
            const bool do_rope = (c8 < rope_end) && !(c8 >= nr_lo && c8 < nr_hi) && ((c8 & 63) < 16);
            const float sc = (c8 < qs_end) ? qscale : 1.0f;
            const int j0 = 4 * ((c8 >> 3) & 1);
            const bool do_wi = (c8 == wi_col);
            const bool do_kit = (c8 >= ki_lo && c8 < ki_lo + 64), do_kv = (c8 >= kv_lo && c8 < kv_lo + 128);
            const int kd = c8 - ki_lo;
#pragma unroll
            for (int ai = 0; ai < 2; ++ai)
#pragma unroll
                for (int m = 0; m < 4; ++m) { const int row = row0 + ai * HALF + m * 16;
                    f32x4 v0 = acc[ai][bj][m][0], v1 = acc[ai][bj][m][1];
                    if (do_rope) { const f32x4 cs = *(const f32x4*)(rope + (size_t)row * 16 + j0), sn = *(const f32x4*)(rope + (size_t)row * 16 + 8 + j0);
                        const f32x4 a0 = v0, a1 = v1;
                        v0[0] = a0[0] * cs[0] - a0[1] * sn[0]; v0[1] = a0[1] * cs[0] + a0[0] * sn[0];
                        v0[2] = a0[2] * cs[1] - a0[3] * sn[1]; v0[3] = a0[3] * cs[1] + a0[2] * sn[1];
                        v1[0] = a1[0] * cs[2] - a1[1] * sn[2]; v1[1] = a1[1] * cs[2] + a1[0] * sn[2];
                        v1[2] = a1[2] * cs[3] - a1[3] * sn[3]; v1[3] = a1[3] * cs[3] + a1[2] * sn[3]; }
                    v0 = v0 * sc; v1 = v1 * sc;
                    if (do_wi) { *(f32x4*)(wi + (size_t)row * 8) = v0 * wscale; *(f32x4*)(wi + (size_t)row * 8 + 4) = v1 * wscale; }
                    u32x4 w; w.x = cvt_pk_bf16(v0[0], v0[1]); w.y = cvt_pk_bf16(v0[2], v0[3]); w.z = cvt_pk_bf16(v1[0], v1[1]); w.w = cvt_pk_bf16(v1[2], v1[3]);
                    *(u32x4*)(O + (size_t)row * ldc + c8) = w;
                    if (do_kit) *(u32x4*)(kit + (size_t)(row >> 12) * (SLAB_EL - 262144) + ((size_t)(row >> 5) * 4 + (kd >> 4)) * 512 + (((kd >> 3) & 1) * 32 + (row & 31)) * 8) = w;
                    if (do_kv) *(u32x4*)(kv + (size_t)(row >> 12) * (SLAB_EL - 524288) + (size_t)row * 128 + (c8 - kv_lo)) = w; }
        }
    }
};

constexpr int F8_SA = 127 - 4, F8_SB = 127 - 6;
typedef int v8i32 __attribute__((ext_vector_type(8))); typedef int v4i32 __attribute__((ext_vector_type(4)));
template <class Epi, class Sched, bool ALIGN_EPI = false, bool SP2 = false, bool F8 = false>
__device__ __forceinline__ void gemm_phase(PG8_LAS unsigned char* lds, const Gemm g, const Sched& S, const Epi& E) {
    int tid_l = threadIdx.x; asm volatile("" : "+v"(tid_l));
    const int tid = tid_l, wid = __builtin_amdgcn_readfirstlane(tid >> 6), lane = tid & 63, wr = wid >> 2, wc = wid & 3, fr = lane & 15, fq = lane >> 4;
    const int K = g.K, nt = K / BK, lda = g.lda;
    unsigned voffA[2], voffB[2];
#pragma unroll
    for (int i = 0; i < 2; ++i) { int R, C; stage_rc(tid * 16 + i * 8192, R, C); const int Rb = Epi::PERM ? ((R & ~31) + perm32(R & 31)) : R;
        voffA[i] = (unsigned)(R * lda + C) * 2u; voffB[i] = (unsigned)(Rb * K + C) * 2u; }
    const size_t kstep = (size_t)(BK * 2);
    const size_t hstep = (size_t)HALF * K * 2;
    const size_t tstep = 2 * hstep;
    const size_t hstepA = (size_t)HALF * lda * 2, tstepA = 2 * hstepA;
    const unsigned ldsw = (unsigned)wid * 1024u;
    const int aoff = lds_byte(wr * 64 + fr, fq * 8), boff = lds_byte(wc * 32 + fr, fq * 8);
#define PG8_SA(b, h) (((b) * 2 + (h)) * HTB)
#define PG8_SB(b, h) ((4 + (b) * 2 + (h)) * HTB)
#define PG8_STAGE(bufoff, gbase, voff) do { _Pragma("unroll") for (int _i = 0; _i < 2; ++_i) \
        __builtin_amdgcn_global_load_lds((const unsigned*)((const char*)(gbase) + (voff)[_i]), (PG8_LAS unsigned*)(lds + (bufoff) + ldsw + _i * 8192), 16, 0, 0); } while (0)
#define PG8_CAT8(X) __builtin_shufflevector(__builtin_bit_cast(v4i32, X[0]), __builtin_bit_cast(v4i32, X[1]), 0, 1, 2, 3, 4, 5, 6, 7)
#define PG8_LDA(dst, b, h) do { _Pragma("unroll") for (int m = 0; m < 4; ++m) { _Pragma("unroll") for (int k = 0; k < 2; ++k) dst[m][k] = *(const PG8_LAS bf16x8*)(lds + PG8_SA(b, h) + aoff + m * 2048 + k * 1024); if constexpr (F8) dst##8[m] = PG8_CAT8(dst[m]); } } while (0)
#define PG8_LDB(dst, b, h) do { _Pragma("unroll") for (int n = 0; n < 2; ++n) { _Pragma("unroll") for (int k = 0; k < 2; ++k) dst[n][k] = *(const PG8_LAS bf16x8*)(lds + PG8_SB(b, h) + boff + n * 2048 + k * 1024); if constexpr (F8) dst##8[n] = PG8_CAT8(dst[n]); } } while (0)
#define PG8_MMA(ai, bj, At, Bt) do { __builtin_amdgcn_s_setprio(1); \
        if constexpr (F8) { _Pragma("unroll") for (int m = 0; m < 4; ++m) _Pragma("unroll") for (int n = 0; n < 2; ++n) \
            asm volatile("v_mfma_scale_f32_16x16x128_f8f6f4 %0, %1, %2, %0, %3, %4 op_sel_hi:[0,0,0]" : "+v"(acc[ai][bj][m][n]) : "v"(Bt##8[n]), "v"(At##8[m]), "v"(f8sb), "v"(f8sa)); }     \
        else { _Pragma("unroll") for (int m = 0; m < 4; ++m) _Pragma("unroll") for (int n = 0; n < 2; ++n) _Pragma("unroll") for (int k = 0; k < 2; ++k) \
            acc[ai][bj][m][n] = __builtin_amdgcn_mfma_f32_16x16x32_bf16(Bt[n][k], At[m][k], acc[ai][bj][m][n], 0, 0, 0); } \
        __builtin_amdgcn_s_setprio(0); } while (0)
#define PG8_WAIT_V(n) asm volatile("s_waitcnt vmcnt(" #n ")" ::: "memory")
#define PG8_WAIT_L(n) asm volatile("s_waitcnt lgkmcnt(" #n ")" ::: "memory")
#define PG8_BAR __builtin_amdgcn_s_barrier()
#define PG8_SCHED __builtin_amdgcn_sched_barrier(0)
    Unit cur, nxt; int ui = 0;
    if (!S.next(0, cur)) return;
    f32x4 acc[2][2][4][2];
#pragma unroll
    for (int a = 0; a < 2; ++a)
#pragma unroll
        for (int b = 0; b < 2; ++b)
#pragma unroll
            for (int m = 0; m < 4; ++m)
#pragma unroll
                for (int n = 0; n < 2; ++n) acc[a][b][m][n] = (f32x4){0.f, 0.f, 0.f, 0.f};
    const int f8sa = F8_SA, f8sb = F8_SB;
    bf16x8 At[4][2], B0[2][2], B1[2][2]; v8i32 At8[4], B08[2], B18[2];
    const char* cA = (const char*)g.A + (size_t)cur.pm * tstepA; const char* cB = (const char*)g.Bt + (size_t)cur.pn * tstep;
    S.a_ready(cur);
    if constexpr (SP2) {
        PG8_STAGE(PG8_SB(0, 0), cB, voffB); PG8_STAGE(PG8_SB(0, 1), cB + hstep, voffB); PG8_STAGE(PG8_SA(0, 0), cA, voffA); PG8_STAGE(PG8_SA(0, 1), cA + hstepA, voffA);
        if (wr == 1) PG8_BAR;
        PG8_WAIT_V(2); PG8_BAR;
        PG8_STAGE(PG8_SB(1, 0), cB + kstep, voffB); PG8_STAGE(PG8_SA(1, 0), cA + kstep, voffA); PG8_STAGE(PG8_SB(1, 1), cB + hstep + kstep, voffB);
        PG8_WAIT_V(6); PG8_BAR;
    } else {
        PG8_STAGE(PG8_SB(0, 0), cB, voffB); PG8_STAGE(PG8_SA(0, 0), cA, voffA); PG8_STAGE(PG8_SB(0, 1), cB + hstep, voffB); PG8_STAGE(PG8_SA(0, 1), cA + hstepA, voffA);
        if (wr == 1) PG8_BAR;
        PG8_WAIT_V(4); PG8_BAR;
        PG8_STAGE(PG8_SB(1, 0), cB + kstep, voffB); PG8_STAGE(PG8_SA(1, 0), cA + kstep, voffA); PG8_STAGE(PG8_SB(1, 1), cB + hstep + kstep, voffB);
        PG8_WAIT_V(6); PG8_BAR;
    }
    for (;;) {
        const bool has_next = S.next(ui + 1, nxt);
        const char* nA = has_next ? (const char*)g.A + (size_t)nxt.pm * tstepA : cA; const char* nB = has_next ? (const char*)g.Bt + (size_t)nxt.pn * tstep : cB;
        for (int t = 0; t < nt; t += 2) {
            const bool last = (t == nt - 2);
            const char* a1 = cA + (size_t)(t + 1) * kstep;
            const char* a2 = last ? nA : cA + (size_t)(t + 2) * kstep; const char* b2 = last ? nB : cB + (size_t)(t + 2) * kstep;
            const char* a3 = a2 + kstep; const char* b3 = b2 + kstep;
            if (last && has_next) S.a_ready(nxt);
            if constexpr (SP2) {
            PG8_LDB(B0, 0, 0); PG8_LDB(B1, 0, 1); PG8_SCHED; PG8_LDA(At, 0, 0); PG8_STAGE(PG8_SA(1, 1), a1 + hstepA, voffA);
            PG8_WAIT_V(8); PG8_WAIT_L(0); PG8_BAR; PG8_MMA(0, 0, At, B0); PG8_MMA(0, 1, At, B1); PG8_BAR; PG8_SCHED;
            PG8_LDA(At, 0, 1); PG8_STAGE(PG8_SB(0, 0), b2, voffB); PG8_STAGE(PG8_SB(0, 1), b2 + hstep, voffB); PG8_STAGE(PG8_SA(0, 0), a2, voffA);
            PG8_WAIT_V(8); PG8_WAIT_L(0); PG8_BAR; PG8_MMA(1, 0, At, B0); PG8_MMA(1, 1, At, B1); PG8_BAR; PG8_SCHED;
            PG8_LDB(B0, 1, 0); PG8_LDB(B1, 1, 1); PG8_SCHED; PG8_LDA(At, 1, 0); PG8_STAGE(PG8_SA(0, 1), a2 + hstepA, voffA);
            PG8_WAIT_V(8); PG8_WAIT_L(0); PG8_BAR; PG8_MMA(0, 0, At, B0); PG8_MMA(0, 1, At, B1); PG8_BAR; PG8_SCHED;
            PG8_LDA(At, 1, 1); PG8_STAGE(PG8_SB(1, 0), b3, voffB); PG8_STAGE(PG8_SB(1, 1), b3 + hstep, voffB); PG8_STAGE(PG8_SA(1, 0), a3, voffA);
            PG8_WAIT_V(8); PG8_WAIT_L(0); PG8_BAR; PG8_MMA(1, 0, At, B0); PG8_MMA(1, 1, At, B1); PG8_BAR; PG8_SCHED;
            } else {
            PG8_LDB(B0, 0, 0); PG8_SCHED; PG8_LDA(At, 0, 0); PG8_STAGE(PG8_SA(1, 1), a1 + hstepA, voffA);
            PG8_WAIT_L(8); PG8_BAR; PG8_WAIT_L(0); PG8_MMA(0, 0, At, B0); PG8_BAR; PG8_SCHED;
            PG8_LDB(B1, 0, 1); PG8_STAGE(PG8_SB(0, 0), b2, voffB);
            PG8_BAR; PG8_WAIT_L(0); PG8_MMA(0, 1, At, B1); PG8_BAR;
            PG8_LDA(At, 0, 1); PG8_STAGE(PG8_SA(0, 0), a2, voffA);
            PG8_BAR; PG8_WAIT_L(0); PG8_MMA(1, 0, At, B0); PG8_BAR; PG8_SCHED;
            PG8_STAGE(PG8_SB(0, 1), b2 + hstep, voffB);
            PG8_WAIT_V(6); PG8_BAR; PG8_MMA(1, 1, At, B1); PG8_BAR;
            PG8_LDB(B0, 1, 0); PG8_SCHED; PG8_LDA(At, 1, 0); PG8_STAGE(PG8_SA(0, 1), a2 + hstepA, voffA);
            PG8_WAIT_L(8); PG8_BAR; PG8_WAIT_L(0); PG8_MMA(0, 0, At, B0); PG8_BAR; PG8_SCHED;
            PG8_LDB(B1, 1, 1); PG8_STAGE(PG8_SB(1, 0), b3, voffB);
            PG8_BAR; PG8_WAIT_L(0); PG8_MMA(0, 1, At, B1); PG8_BAR;
            PG8_LDA(At, 1, 1); PG8_STAGE(PG8_SA(1, 0), a3, voffA);
            PG8_BAR; PG8_WAIT_L(0); PG8_MMA(1, 0, At, B0); PG8_BAR; PG8_SCHED;
            PG8_STAGE(PG8_SB(1, 1), b3 + hstep, voffB);
            PG8_WAIT_V(6); PG8_BAR; PG8_MMA(1, 1, At, B1); PG8_BAR;
            }
        }
        if constexpr (ALIGN_EPI) { if (wr == 0) PG8_BAR; }
        if constexpr (F8) asm volatile("s_nop 15\n\ts_nop 15\n\ts_nop 15" ::: "memory");
        if constexpr (!Epi::AFTER_DRAIN) { E(acc, cur, wr, wc, fr, fq); S.done(cur); }
        if (!has_next) break;
#pragma unroll
        for (int a = 0; a < 2; ++a)
#pragma unroll
            for (int b = 0; b < 2; ++b)
#pragma unroll
                for (int m = 0; m < 4; ++m)
#pragma unroll
                    for (int n = 0; n < 2; ++n) acc[a][b][m][n] = (f32x4){0.f, 0.f, 0.f, 0.f};
        cur = nxt; cA = nA; cB = nB; ++ui;
        if constexpr (ALIGN_EPI) { if (wr == 1) PG8_BAR; }
    }
    PG8_WAIT_V(0);
    if constexpr (!ALIGN_EPI) { if (wr == 0) PG8_BAR; }
    PG8_BAR;
    if constexpr (Epi::AFTER_DRAIN) { E.fused(acc, cur, wr, wc, fr, fq, lds, wid, lane); S.done(cur); }
#undef PG8_SA
#undef PG8_SB
#undef PG8_STAGE
#undef PG8_LDA
#undef PG8_LDB
#undef PG8_MMA
#undef PG8_CAT8
#undef PG8_WAIT_V
#undef PG8_WAIT_L
#undef PG8_BAR
#undef PG8_SCHED
}
}

namespace attn_body {
using bf16=__hip_bfloat16;
using bf16x8=__attribute__((ext_vector_type(8)))short;
using s16x4=__attribute__((ext_vector_type(4)))short;
using f32x16=__attribute__((ext_vector_type(16)))float;
using u32x4=__attribute__((ext_vector_type(4)))unsigned;
constexpr int BATCH=8,NCH=16,SEQ=4096,D=64,DV=128,QKVP=3072,OP=1024;
constexpr int NW=8,QBLK=32,QB=QBLK*NW,KVBLK=64,NQB=SEQ/QB;
constexpr int ATTN_UNIT_ROWS=QB;
__device__ __forceinline__ int crow(int r,int hi){return (r&3)+8*(r>>2)+4*hi;}
#define SBAR() __builtin_amdgcn_sched_barrier(0)
__device__ __forceinline__ void cmask(f32x16&p0,f32x16&p1,int jb,int qrel,int hi){
  const float NEG=-INFINITY; int kb=64*jb+4*hi;
  #pragma unroll
  for(int r=0;r<16;++r){int kv=kb+(r&3)+8*(r>>2); if(kv>qrel)p0[r]=NEG; if(kv+32>qrel)p1[r]=NEG;}
}

constexpr int NSLOT=3, SLOTB=8192, VSLOTB=2*SLOTB;
constexpr int LDS_K=0, LDS_V=NSLOT*SLOTB, LDS_WS=LDS_V+NSLOT*VSLOTB, LDS_BYTES=LDS_WS+NW*64*4+512, LDS_OST=0;
static_assert(NW*8192<=LDS_WS,"O stage inside the ring area");
constexpr float C2=0.125f*1.4426950408889634f;
__device__ __forceinline__ void glds16(const void*gsrc,unsigned lds_dst){unsigned keep;
  asm volatile("s_mov_b32 %0, m0\n\ts_mov_b32 m0, %2\n\ts_nop 0\n\tglobal_load_lds_dwordx4 %1, off\n\ts_mov_b32 m0, %0":"=&s"(keep):"v"(gsrc),"s"(lds_dst):"memory");}
__device__ __forceinline__ float max3f(float a,float b,float c){float r;asm("v_max3_f32 %0, %1, %2, %3":"=v"(r):"v"(a),"v"(b),"v"(c));return r;}
__device__ __forceinline__ float max2f(float a,float b){float r;asm("v_max_f32_e32 %0, %1, %2":"=v"(r):"v"(a),"v"(b));return r;}
__device__ __forceinline__ float fadd_s(float a,float b){float r;asm("v_add_f32_e32 %0, %1, %2":"=v"(r):"v"(a),"v"(b));return r;}
__device__ __forceinline__ float fsub_s(float a,float b){float r;asm("v_sub_f32_e32 %0, %1, %2":"=v"(r):"v"(a),"v"(b));return r;}
typedef float f32x2_t __attribute__((ext_vector_type(2))); typedef __bf16 bf16x2_t __attribute__((ext_vector_type(2)));
__device__ __forceinline__ unsigned cvtpk_s(float lo,float hi){f32x2_t v={lo,hi};bf16x2_t b=__builtin_convertvector(v,bf16x2_t);return __builtin_bit_cast(unsigned,b);}
#define WAIT_BAR(N) asm volatile("s_waitcnt vmcnt(" #N ") lgkmcnt(0)\n\ts_barrier":::"memory")

__device__ __forceinline__ void qkt(f32x16&p0,f32x16&p1,const char*Kslot,const bf16x8*qr,int r32,int hi){
  const f32x16 zc=f32x16{};
  const char*kb=Kslot+hi*1024+r32*16;
  #pragma unroll
  for(int d0=0;d0<4;++d0){
    const bf16x8 b0=*reinterpret_cast<const bf16x8*>(kb+d0*2048);
    const bf16x8 b1=*reinterpret_cast<const bf16x8*>(kb+d0*2048+512);
    if(d0==0){p0=__builtin_amdgcn_mfma_f32_32x32x16_bf16(b0,qr[0],zc,0,0,0);p1=__builtin_amdgcn_mfma_f32_32x32x16_bf16(b1,qr[0],zc,0,0,0);}
    else{p0=__builtin_amdgcn_mfma_f32_32x32x16_bf16(b0,qr[d0],p0,0,0,0);p1=__builtin_amdgcn_mfma_f32_32x32x16_bf16(b1,qr[d0],p1,0,0,0);}}
}
typedef __attribute__((address_space(3))) const char* lds_cptr;
typedef short v4i16_t __attribute__((ext_vector_type(4)));
__device__ __forceinline__ void kload8(bf16x8*kf,lds_cptr kp){
  kf[0]=*(const __attribute__((address_space(3))) bf16x8*)(kp);      kf[1]=*(const __attribute__((address_space(3))) bf16x8*)(kp+512);
  kf[2]=*(const __attribute__((address_space(3))) bf16x8*)(kp+2048); kf[3]=*(const __attribute__((address_space(3))) bf16x8*)(kp+2560);
  kf[4]=*(const __attribute__((address_space(3))) bf16x8*)(kp+4096); kf[5]=*(const __attribute__((address_space(3))) bf16x8*)(kp+4608);
  kf[6]=*(const __attribute__((address_space(3))) bf16x8*)(kp+6144); kf[7]=*(const __attribute__((address_space(3))) bf16x8*)(kp+6656);
}
__device__ __forceinline__ void kload2(bf16x8*kf,lds_cptr kp,int j){ kf[2*j]=*(const __attribute__((address_space(3))) bf16x8*)(kp+j*2048); kf[2*j+1]=*(const __attribute__((address_space(3))) bf16x8*)(kp+j*2048+512); }
__device__ __forceinline__ s16x4 vtr(lds_cptr p){ return __builtin_bit_cast(s16x4,__builtin_amdgcn_ds_read_tr16_b64_v4i16((__attribute__((address_space(3))) v4i16_t*)p)); }
__device__ __forceinline__ float rowmax(const f32x16&p0,const f32x16&p1){
  float a=max3f(p0[0],p0[1],p1[0]),b=max3f(p0[2],p0[3],p1[1]);a=max3f(a,p1[2],p1[3]);
  #pragma unroll
  for(int r=4;r<16;r+=4){a=max3f(a,p0[r],p0[r+1]);b=max3f(b,p0[r+2],p0[r+3]);a=max3f(a,p1[r],p1[r+1]);b=max3f(b,p1[r+2],p1[r+3]);}
  const float m=max2f(a,b);
  auto rr=__builtin_amdgcn_permlane32_swap(__float_as_uint(m),__float_as_uint(m),false,false);
  return max2f(__uint_as_float(rr[0]),__uint_as_float(rr[1]));
}
__device__ __forceinline__ void pv(f32x16*o,int vb,bf16x8 pa0,bf16x8 pa1,bf16x8 pa2,bf16x8 pa3){
  #pragma unroll
  for(int d0=0;d0<4;++d0){s16x4 lo[4],hi[4];
    #pragma unroll
    for(int ks=0;ks<4;++ks){
      asm volatile("ds_read_b64_tr_b16 %0,%1 offset:%c2":"=&v"(lo[ks]):"v"(vb),"i"(d0*4096+ks*1024):"memory");
      asm volatile("ds_read_b64_tr_b16 %0,%1 offset:%c2":"=&v"(hi[ks]):"v"(vb),"i"(d0*4096+ks*1024+512):"memory");}
    asm volatile("s_waitcnt lgkmcnt(0)":::"memory");SBAR();
    #define PK(k) (bf16x8){lo[k][0],lo[k][1],lo[k][2],lo[k][3],hi[k][0],hi[k][1],hi[k][2],hi[k][3]}
    o[d0]=__builtin_amdgcn_mfma_f32_32x32x16_bf16(pa0,PK(0),o[d0],0,0,0);
    o[d0]=__builtin_amdgcn_mfma_f32_32x32x16_bf16(pa1,PK(1),o[d0],0,0,0);
    o[d0]=__builtin_amdgcn_mfma_f32_32x32x16_bf16(pa2,PK(2),o[d0],0,0,0);
    o[d0]=__builtin_amdgcn_mfma_f32_32x32x16_bf16(pa3,PK(3),o[d0],0,0,0);
    #undef PK
  }
}

#ifndef ATTN_STORE16
#define ATTN_STORE16(p,v) (*(u32x4*)(p)=(v))
#endif
template<int THRL> __device__ __forceinline__ void attn_unit(int b,int qoff,int koff,int voff,int ooff,int qb,const bf16*Q,const bf16*__restrict__ K,const bf16*__restrict__ V,bf16*O,char*shm,bool comb,bf16*OUT,float lam,const float*gsv){
  int tid_l=threadIdx.x; asm volatile("":"+v"(tid_l)); const int tid=tid_l,lane=tid&63,r32=lane&31,hi=lane>>5; const int wid=__builtin_amdgcn_readfirstlane(tid>>6);
  const long rowbase=(long)b*SEQ; const int q0=qb*QB;
  const bf16*Qw=Q+(rowbase+q0+wid*QBLK)*QKVP+qoff;
  const bf16*Kh=K+rowbase*QKVP+koff,*Vh=V+rowbase*QKVP+voff;
  const unsigned lds0=(unsigned)(uintptr_t)shm;
  float*wsf=(float*)(shm+LDS_WS)+wid*64;
  const bf16*ksrc=Kh+(long)lane*QKVP+wid*8;
  const bf16*vsrc=Vh+(long)(16*(wid&3)+(lane>>2))*QKVP+(wid>>2)*32+(lane&3)*8;
  const unsigned kdst=lds0+LDS_K+wid*1024, vdst=lds0+LDS_V+wid*1024;
  #define DMA_K(t,slot) glds16(ksrc+(long)(t)*KVBLK*QKVP,(unsigned)__builtin_amdgcn_readfirstlane(kdst+(slot)))
  #define DMA_V(t,slot) do{ glds16(vsrc+(long)(t)*KVBLK*QKVP,(unsigned)__builtin_amdgcn_readfirstlane(vdst+2*(slot))); glds16(vsrc+(long)(t)*KVBLK*QKVP+64,(unsigned)__builtin_amdgcn_readfirstlane(vdst+2*(slot)+8192)); }while(0)
  const int vb0=(int)(lds0+LDS_V)+((lane>>4)&1)*32+(lane&3)*8+(4*hi+((lane&15)>>2))*64;
  const char*Kbase=shm+LDS_K; bf16x8 kf[8];
  const lds_cptr shm3=(lds_cptr)shm; const lds_cptr kp0=shm3+LDS_K+hi*1024+r32*16; const lds_cptr vp0=shm3+LDS_V+((lane>>4)&1)*32+(lane&3)*8+(4*hi+((lane&15)>>2))*64;
  const int NT=(q0+QB)/KVBLK;
  DMA_K(0,0);DMA_V(0,0);DMA_K(1,SLOTB);
  bf16x8 qr[4];
  #pragma unroll
  for(int d0=0;d0<4;++d0)qr[d0]=*reinterpret_cast<const bf16x8*>(&Qw[(long)r32*QKVP+d0*16+hi*8]);
  float mhat=0.f,l_reg=0.f;f32x16 o[4];o[0]=f32x16{};o[1]=f32x16{};o[2]=f32x16{};o[3]=f32x16{};
  const int qrel=wid*QBLK+r32;
  #define CMASK(P0,P1,t) do{int jb_=(t)-(NT-4); if(jb_>=0)cmask(P0,P1,jb_,qrel,hi);}while(0)
  bool resc=false;
  #define START(P0,P1) do{ const float rm=rowmax(P0,P1); resc=false; \
    { const float dl=rm; mhat=fadd_s(mhat,dl); \
      _Pragma("unroll") for(int r=0;r<16;++r){P0[r]=fsub_s(P0[r],dl);P1[r]=fsub_s(P1[r],dl);} } \
    _Pragma("unroll") for(int r=0;r<16;++r)P0[r]=__builtin_amdgcn_exp2f(P0[r]); }while(0)
  #define RESC() do{ if(resc){ asm volatile("s_waitcnt lgkmcnt(0)":::"memory"); \
      _Pragma("unroll") for(int d_=0;d_<4;++d_) _Pragma("unroll") for(int r=0;r<16;++r)o[d_][r]*=wsf[crow(r,hi)]; } }while(0)
  f32x16 pA0,pA1,pB0,pB1; const f32x16 zero16=f32x16{};
  int sl_prev=0,sl_cur=0,sl_next=SLOTB;
  #define ROT() do{sl_prev=sl_cur;sl_cur=sl_next;sl_next=(sl_next==(NSLOT-1)*SLOTB)?0:sl_next+SLOTB;}while(0)
  DMA_K(2,2*SLOTB);
  WAIT_BAR(4);
  qkt(pA0,pA1,Kbase,qr,r32,hi);asm volatile("s_nop 15\n\ts_nop 7":"+v"(pA0),"+v"(pA1));CMASK(pA0,pA1,0);
  START(pA0,pA1);
  _Pragma("unroll") for(int r=0;r<16;++r)pA1[r]=__builtin_amdgcn_exp2f(pA1[r]);
  WAIT_BAR(0);
  DMA_K(3,0);DMA_V(1,SLOTB);
  ROT();
  kload8(kf,kp0+sl_cur);
  WAIT_BAR(3);
  s16x4 vlo[8],vhi[8]; u32x4 pw0,pw1,pw2,pw3;
  #define PKW(P,B) cvtpk_s(P[B],P[B+1])
  #define PAF(k) __builtin_bit_cast(bf16x8,pw##k)
  #define VFR(i) (bf16x8){vlo[i][0],vlo[i][1],vlo[i][2],vlo[i][3],vhi[i][0],vhi[i][1],vhi[i][2],vhi[i][3]}
  #define PIN(x) asm volatile("":"+v"(x))
  #define MX3(a,b,c) __builtin_fmaxf(__builtin_fmaxf((a),(b)),(c))
  #define GAPA(MF,A0,A1,A2,A3,W0,W1,PW) do{ MF; sacc+=A0; sacc+=A1; sacc+=A2; sacc+=A3; PIN(sacc); W0; W1; PIN(PW); SBAR(); }while(0)
  #define EX(v) __builtin_amdgcn_exp2f(v)
  #define GAPB(MF,X,B,EXTRA) do{ MF; X[B]=EX(X[B]); X[B+1]=EX(X[B+1]); EXTRA; PIN(X); SBAR(); }while(0)
  #define VLD(i,f) do{ vlo[i]=vtr(vp_+(((f)>>2)*4096+((f)&3)*1024)); vhi[i]=vtr(vp_+(((f)>>2)*4096+((f)&3)*1024+512)); }while(0)
  #define VRD(i) do{ vlo[i]=vtr(vp_+(((i)>>2)*4096+((i)&3)*1024)); vhi[i]=vtr(vp_+(((i)>>2)*4096+((i)&3)*1024+512)); }while(0)
  #define KRD(G,j) do{ if(G){ kload2(kf,kp0+sl_next,j); SBAR(); } }while(0)
  #define STEP(C0,C1,P0,P1,t,GK,GV,GL) do{ SBAR(); \
    const lds_cptr vp_=vp0+2*sl_prev; \
    VRD(0); SBAR(); float sacc=(P0[0]+P0[1]); \
    GAPA(C0=__builtin_amdgcn_mfma_f32_32x32x16_bf16(kf[0],qr[0],zero16,0,0,0), P0[2],P0[3],P0[4],P0[5],     pw0[0]=PKW(P0,0), pw0[1]=PKW(P0,2), pw0); \
    VRD(4); SBAR(); GAPA(C1=__builtin_amdgcn_mfma_f32_32x32x16_bf16(kf[1],qr[0],zero16,0,0,0), P0[6],P0[7],P0[8],P0[9],     pw0[2]=PKW(P0,4), pw0[3]=PKW(P0,6), pw0); \
    VRD(1); SBAR(); GAPA(C0=__builtin_amdgcn_mfma_f32_32x32x16_bf16(kf[2],qr[1],C0,0,0,0),   P0[10],P0[11],P0[12],P0[13], pw1[0]=PKW(P0,8), pw1[1]=PKW(P0,10), pw1); \
    VRD(5); SBAR(); GAPA(C1=__builtin_amdgcn_mfma_f32_32x32x16_bf16(kf[3],qr[1],C1,0,0,0),   P0[14],P0[15],P1[0],P1[1],   pw1[2]=PKW(P0,12),pw1[3]=PKW(P0,14), pw1); \
    GAPA(C0=__builtin_amdgcn_mfma_f32_32x32x16_bf16(kf[4],qr[2],C0,0,0,0),   P1[2],P1[3],P1[4],P1[5],     pw2[0]=PKW(P1,0), pw2[1]=PKW(P1,2), pw2); \
    GAPA(C1=__builtin_amdgcn_mfma_f32_32x32x16_bf16(kf[5],qr[2],C1,0,0,0),   P1[6],P1[7],P1[8],P1[9],     pw2[2]=PKW(P1,4), pw2[3]=PKW(P1,6), pw2); \
    GAPA(C0=__builtin_amdgcn_mfma_f32_32x32x16_bf16(kf[6],qr[3],C0,0,0,0),   P1[10],P1[11],P1[12],P1[13], pw3[0]=PKW(P1,8), pw3[1]=PKW(P1,10), pw3); \
    GAPA(C1=__builtin_amdgcn_mfma_f32_32x32x16_bf16(kf[7],qr[3],C1,0,0,0),   P1[14],P1[15],0.f,0.f,       pw3[2]=PKW(P1,12),pw3[3]=PKW(P1,14), pw3); \
    l_reg+=sacc; \
    if(GK){DMA_K((t)+3,sl_cur);} if(GV){DMA_V((t)+1,sl_next);} \
    CMASK(C0,C1,t); \
    { float a=MX3(C0[0],C0[1],C1[0]),b=MX3(C0[2],C0[3],C1[1]); a=MX3(a,C1[2],C1[3]); \
      _Pragma("unroll") for(int r=4;r<16;r+=4){a=MX3(a,C0[r],C0[r+1]);b=MX3(b,C0[r+2],C0[r+3]);a=MX3(a,C1[r],C1[r+1]);b=MX3(b,C1[r+2],C1[r+3]);} \
      float rm=__builtin_fmaxf(a,b); { auto rr=__builtin_amdgcn_permlane32_swap(__float_as_uint(rm),__float_as_uint(rm),false,false); rm=__builtin_fmaxf(__uint_as_float(rr[0]),__uint_as_float(rr[1])); } \
      rm-=mhat; resc=false;     \
      if(__builtin_expect(__any(rm>(float)THRL),0)){ const float dl=__builtin_fmaxf(rm,0.f); mhat+=dl; \
        const float f=__builtin_amdgcn_exp2f(-dl); l_reg*=f; if(hi==0)wsf[r32]=f; resc=true; } \
      C0=C0-mhat; C1=C1-mhat; } \
    SBAR(); \
    GAPB(o[0]=__builtin_amdgcn_mfma_f32_32x32x16_bf16(PAF(0),VFR(0),o[0],0,0,0), C0,0, VLD(2,2)); \
    GAPB(o[1]=__builtin_amdgcn_mfma_f32_32x32x16_bf16(PAF(0),VFR(4),o[1],0,0,0), C0,2, VLD(6,6)); \
    KRD(GL,0); GAPB(o[0]=__builtin_amdgcn_mfma_f32_32x32x16_bf16(PAF(1),VFR(1),o[0],0,0,0), C0,4, VLD(3,3)); \
    KRD(GL,1); GAPB(o[1]=__builtin_amdgcn_mfma_f32_32x32x16_bf16(PAF(1),VFR(5),o[1],0,0,0), C0,6, VLD(7,7)); \
    KRD(GL,2); GAPB(o[0]=__builtin_amdgcn_mfma_f32_32x32x16_bf16(PAF(2),VFR(2),o[0],0,0,0), C0,8, VLD(0,8)); \
    KRD(GL,3); GAPB(o[1]=__builtin_amdgcn_mfma_f32_32x32x16_bf16(PAF(2),VFR(6),o[1],0,0,0), C0,10, VLD(4,12)); \
    GAPB(o[0]=__builtin_amdgcn_mfma_f32_32x32x16_bf16(PAF(3),VFR(3),o[0],0,0,0), C0,12, VLD(1,9)); \
    GAPB(o[1]=__builtin_amdgcn_mfma_f32_32x32x16_bf16(PAF(3),VFR(7),o[1],0,0,0), C0,14, VLD(5,13)); \
    GAPB(o[2]=__builtin_amdgcn_mfma_f32_32x32x16_bf16(PAF(0),VFR(0),o[2],0,0,0), C1,0, VLD(2,10)); \
    GAPB(o[3]=__builtin_amdgcn_mfma_f32_32x32x16_bf16(PAF(0),VFR(4),o[3],0,0,0), C1,2, VLD(6,14)); \
    GAPB(o[2]=__builtin_amdgcn_mfma_f32_32x32x16_bf16(PAF(1),VFR(1),o[2],0,0,0), C1,4, VLD(3,11)); \
    GAPB(o[3]=__builtin_amdgcn_mfma_f32_32x32x16_bf16(PAF(1),VFR(5),o[3],0,0,0), C1,6, VLD(7,15)); \
    GAPB(o[2]=__builtin_amdgcn_mfma_f32_32x32x16_bf16(PAF(2),VFR(2),o[2],0,0,0), C1,8, (void)0); \
    GAPB(o[3]=__builtin_amdgcn_mfma_f32_32x32x16_bf16(PAF(2),VFR(6),o[3],0,0,0), C1,10, (void)0); \
    GAPB(o[2]=__builtin_amdgcn_mfma_f32_32x32x16_bf16(PAF(3),VFR(3),o[2],0,0,0), C1,12, (void)0); \
    GAPB(o[3]=__builtin_amdgcn_mfma_f32_32x32x16_bf16(PAF(3),VFR(7),o[3],0,0,0), C1,14, (void)0); \
    }while(0)
  int t=1;
  #undef CMASK
  #define CMASK(P0,P1,t) do{}while(0)
  for(;t+5<NT;t+=2){
    STEP(pB0,pB1,pA0,pA1,t,true,true,true);     WAIT_BAR(3); RESC(); ROT();
    STEP(pA0,pA1,pB0,pB1,t+1,true,true,true);   WAIT_BAR(3); RESC(); ROT();
  }
  #undef CMASK
  #define CMASK(P0,P1,t) do{int jb_=(t)-(NT-4); if(jb_>=0)cmask(P0,P1,jb_,qrel,hi);}while(0)
  #define ENDW(tt) do{ if((tt)+3<NT){WAIT_BAR(3);} else if((tt)+2<NT){WAIT_BAR(2);} else {WAIT_BAR(0);} }while(0)
  for(;t+1<NT;t+=2){
    STEP(pB0,pB1,pA0,pA1,t,(t+3<NT),(t+1<NT),(t+1<NT));       ENDW(t);   RESC(); ROT();
    STEP(pA0,pA1,pB0,pB1,t+1,(t+4<NT),(t+2<NT),(t+2<NT));     ENDW(t+1); RESC(); ROT();
  }
  STEP(pB0,pB1,pA0,pA1,NT-1,false,false,false); RESC();
  { float sacc=pB0[0]+pB0[1]; _Pragma("unroll") for(int r=2;r<16;++r)sacc+=pB0[r]; _Pragma("unroll") for(int r=0;r<16;++r)sacc+=pB1[r]; l_reg+=sacc;
    pw0=(u32x4){PKW(pB0,0),PKW(pB0,2),PKW(pB0,4),PKW(pB0,6)};pw1=(u32x4){PKW(pB0,8),PKW(pB0,10),PKW(pB0,12),PKW(pB0,14)};pw2=(u32x4){PKW(pB1,0),PKW(pB1,2),PKW(pB1,4),PKW(pB1,6)};pw3=(u32x4){PKW(pB1,8),PKW(pB1,10),PKW(pB1,12),PKW(pB1,14)};
    SBAR(); pv(o,vb0+2*sl_cur,PAF(0),PAF(1),PAF(2),PAF(3)); }
  #undef PKW
  #undef PAF
  #undef VFR
  #undef PIN
  #undef MX3
  #undef GAPA
  #undef GAPB
  #undef EX
  #undef VRD
  #undef VLD
  #undef KRD
  #undef STEP
  #undef ENDW
  {auto rr=__builtin_amdgcn_permlane32_swap(__float_as_uint(l_reg),__float_as_uint(l_reg),false,false);l_reg=__uint_as_float(rr[0])+__uint_as_float(rr[1]);}
  if(hi==0)wsf[32+r32]=l_reg;asm volatile("s_waitcnt lgkmcnt(0)":::"memory");
  float rli[16];
  #pragma unroll
  for(int r=0;r<16;++r)rli[r]=__builtin_amdgcn_rcpf(wsf[32+crow(r,hi)]);
  bf16*Ow=O+(rowbase+q0+wid*QBLK)*OP+ooff;
  asm volatile("s_waitcnt lgkmcnt(0)\n\ts_barrier":::"memory");
  { bf16*stg=(bf16*)(shm+LDS_OST)+wid*4096;
    #pragma unroll
    for(int r=0;r<16;++r){const int orow=crow(r,hi);
      #pragma unroll
      for(int d0=0;d0<4;++d0)stg[orow*128+d0*32+r32]=__float2bfloat16(o[d0][r]*rli[r]);}
    asm volatile("s_waitcnt lgkmcnt(0)":::"memory");
    if(!comb){
      #pragma unroll
      for(int i=0;i<8;++i){const int row=i*4+(lane>>4),ch=lane&15; const u32x4 v=*(const u32x4*)(stg+row*128+ch*8); ATTN_STORE16(Ow+(long)row*OP+ch*8,v);}
    } else {
      const int ch=lane&15; float gs[8];
      #pragma unroll
      for(int k=0;k<8;++k)gs[k]=gsv[ch*8+k];
      bf16*Uw=OUT+(rowbase+q0+wid*QBLK)*OP+ooff;
      asm volatile("s_waitcnt vmcnt(0)":::"memory");
      #pragma unroll
      for(int i=0;i<8;++i){const int row=i*4+(lane>>4);
        const u32x4 v1=*(const u32x4*)(stg+row*128+ch*8); const u32x4 v0=*(const u32x4*)(Ow+(long)row*OP+ch*8);
        float d[8]; float ss=0.f;
        #pragma unroll
        for(int k=0;k<4;++k){ const unsigned a=v0[k], c1=v1[k];
          d[2*k]=__uint_as_float(a<<16)-lam*__uint_as_float(c1<<16); d[2*k+1]=__uint_as_float(a&0xffff0000u)-lam*__uint_as_float(c1&0xffff0000u);
          ss+=d[2*k]*d[2*k]+d[2*k+1]*d[2*k+1]; }
        ss+=__shfl_xor(ss,1); ss+=__shfl_xor(ss,2); ss+=__shfl_xor(ss,4); ss+=__shfl_xor(ss,8);
        const float rs=1.0f/sqrtf(ss*(1.0f/128.0f)+1e-6f);
        u32x4 w;
        #pragma unroll
        for(int k=0;k<4;++k) w[k]=cvtpk_s(d[2*k]*rs*gs[2*k],d[2*k+1]*rs*gs[2*k+1]);
        ATTN_STORE16(Uw+(long)row*OP+ch*8,w); }
    } }
  asm volatile("s_waitcnt lgkmcnt(0)\n\ts_barrier":::"memory");
  #undef DMA_K
  #undef DMA_V
  #undef CMASK
  #undef START
  #undef RESC
  #undef ROT
}
constexpr int ATTN_LDS_BYTES=LDS_BYTES;
struct AttnTensors { const bf16* Q; const bf16* K; const bf16* V; bf16* O0; bf16* OUT; const float* lam; const float* subln; int layer_idx; };
template<int THRL=8> __device__ __forceinline__ void attn_phase(char*lds,const AttnTensors&T,int vcu,int G){
  float lam_val, lam_init;
  int tx=threadIdx.x; asm volatile("":"+v"(tx));
  { const int lane=tx&63; float s01=T.lam[lane]*T.lam[64+lane], s23=T.lam[128+lane]*T.lam[192+lane];
    #pragma unroll
    for(int o=1;o<64;o<<=1){ s01+=__shfl_xor(s01,o); s23+=__shfl_xor(s23,o); }
    lam_init=0.8f-0.6f*__expf(-0.3f*(float)T.layer_idx); lam_val=__expf(s01)-__expf(s23)+lam_init; }
  float* gsv=(float*)(lds+LDS_WS+NW*256);
  if(tx<128) gsv[tx]=T.subln[tx]*(1.0f-lam_init);
  __syncthreads();
  const int ni=(G==256)?4:(BATCH*8*NQB-vcu+G-1)/G;
  for(int i2=0;i2<2*ni;++i2){
    const int i=i2>>1, c=i2&1; int b,h,qb;
    if(G==256){ b=vcu>>5; h=(vcu&31)>>2; const int q=vcu&3; qb=(i==0)?15-q:(i==1)?8+q:(i==2)?7-q:q; }
    else{ const int uid=vcu+i*G; qb=uid&15; h=(uid>>4)&7; b=uid>>7; }
    attn_unit<THRL>(b,(c*8+h)*64,(c*8+h)*64,h*128,h*128,qb,T.Q,T.K,T.V,T.O0,lds,c!=0,T.OUT,lam_val,gsv);
  }
}
#undef SBAR
#undef WAIT_BAR
}

#define GAS __attribute__((address_space(1)))
#define LAS __attribute__((address_space(3)))
typedef unsigned short bf16;
typedef unsigned v4u __attribute__((ext_vector_type(4)));
typedef float f32x4 __attribute__((ext_vector_type(4)));
typedef short bf16x8 __attribute__((ext_vector_type(8)));
typedef GAS unsigned gu32;
typedef GAS unsigned long long gu64;
#define RLX_AGENT __ATOMIC_RELAXED, __HIP_MEMORY_SCOPE_AGENT
#define LDS_WAIT() asm volatile("s_waitcnt lgkmcnt(0)" ::: "memory")
#define VM_WAIT() asm volatile("s_waitcnt vmcnt(0)" ::: "memory")
__device__ __forceinline__ unsigned long long rt() { return __builtin_amdgcn_s_memrealtime(); }
__device__ __forceinline__ unsigned f2bf(float f) { unsigned u = __builtin_bit_cast(unsigned, f); return (u + 0x7fffu + ((u >> 16) & 1u)) >> 16; }
__device__ __forceinline__ unsigned pk2(float lo, float hi) { return f2bf(lo) | (f2bf(hi) << 16); }

#define XB_TMO      128
#define XB_XCNT(j)  (256  + 64 * (j))
#define XB_XSUB(j)  (1280 + 64 * (j))
#define XB_XGEN(j)  (2304 + 64 * (j))
#define XB_TOP      3328
#define XB_TOPGEN   3392
#define XCD_BAR_WORDS 3456
#define XB_SPIN_CAP (1u << 18)

__device__ __forceinline__ unsigned xb_ld(unsigned* p)              { return __hip_atomic_load(p, __ATOMIC_RELAXED, __HIP_MEMORY_SCOPE_AGENT); }
__device__ __forceinline__ unsigned xb_add(unsigned* p, unsigned v) { return __hip_atomic_fetch_add(p, v, __ATOMIC_RELAXED, __HIP_MEMORY_SCOPE_AGENT); }
__device__ __forceinline__ unsigned xb_xcc_id() { return (unsigned)__builtin_amdgcn_s_getreg((3 << 11) | 20) & 0xFu; }
#define XB_SPIN(cond, bar) do { unsigned _sp = 0; while (cond) { __builtin_amdgcn_s_sleep(1); \
    if ((++_sp & 255u) == 0u) { if (xb_ld(&(bar)[XB_TMO])) break; if (_sp > XB_SPIN_CAP) { atomicAdd(&(bar)[XB_TMO], 1u); break; } } } } while (0)

struct XcdBarrier {
    unsigned* bar; unsigned x;
    volatile LAS unsigned* st;
};

__device__ __forceinline__ XcdBarrier xcd_barrier_post(unsigned* bar, volatile LAS unsigned* st) {
    XcdBarrier b; b.bar = bar; b.x = xb_xcc_id(); b.st = st;
    if (threadIdx.x == 0) st[2] = xb_add(&bar[XB_XCNT(b.x)], 1u);
    return b;
}
__device__ __forceinline__ void xcd_barrier_complete(unsigned* bar, unsigned x, unsigned& nloc, unsigned& nx, bool& uni) {
    const unsigned G = gridDim.x * gridDim.y * gridDim.z;
    unsigned sum, cnt, mine, odd, sp = 0u;
    for (;;) {
        sum = 0u; cnt = 0u; mine = 0u; odd = 0u;
#pragma unroll
        for (unsigned j = 0; j < 16; ++j) { const unsigned c = xb_ld(&bar[XB_XCNT(j)]); sum += c; cnt += (c > 0u) ? 1u : 0u; mine = (j == x) ? c : mine; odd += (c != 0u && (c != 32u || j >= 8u)) ? 1u : 0u; }
        if (sum == G) break;
        __builtin_amdgcn_s_sleep(1);
        if ((++sp & 255u) == 0u) { if (xb_ld(&bar[XB_TMO])) break; if (sp > XB_SPIN_CAP) { atomicAdd(&bar[XB_TMO], 1u); break; } }
    }
    nloc = mine > 0u ? mine : 1u; nx = cnt > 0u ? cnt : 1u;
    uni = (sum == G) && (G == 256u) && (cnt == 8u) && (odd == 0u);
}

__device__ __forceinline__ void xcd_barrier(const XcdBarrier& b) {
    asm volatile("s_waitcnt vmcnt(0)" ::: "memory");
    __syncthreads();
    if (threadIdx.x == 0) {
        unsigned* bar = b.bar;
        __builtin_amdgcn_s_waitcnt(0);
        unsigned nloc = b.st[0], nx = b.st[1];
        if (nloc == 0u) { bool uni; xcd_barrier_complete(bar, b.x, nloc, nx, uni); b.st[0] = nloc; b.st[1] = nx; b.st[3] = uni ? 1u + b.st[2] * 8u + b.x : 0u; }
        const unsigned old = xb_add(&bar[XB_XSUB(b.x)], 1u);
        const unsigned gen = old / nloc;
        if (old + 1u == (gen + 1u) * nloc) {
            __builtin_amdgcn_fence(__ATOMIC_RELEASE, "agent");
            asm volatile("s_waitcnt vmcnt(0)" ::: "memory");
            const unsigned og = xb_add(&bar[XB_TOP], 1u);
            const unsigned tg = og / nx;
            if (og + 1u == (tg + 1u) * nx) xb_add(&bar[XB_TOPGEN], 1u);
            else XB_SPIN(xb_ld(&bar[XB_TOPGEN]) == tg, bar);
            __builtin_amdgcn_fence(__ATOMIC_ACQUIRE, "agent");
            xb_add(&bar[XB_XGEN(b.x)], 1u);
            asm volatile("s_waitcnt vmcnt(0)" ::: "memory");
        } else {
            XB_SPIN(xb_ld(&bar[XB_XGEN(b.x)]) == gen, bar);
            __builtin_amdgcn_fence(__ATOMIC_ACQUIRE, "agent");
            asm volatile("s_waitcnt vmcnt(0)" ::: "memory");
        }
    }
    __syncthreads();
}

__device__ __forceinline__ unsigned lds_word_uniform(unsigned byte_addr) { unsigned a = byte_addr; asm volatile("" : "+s"(a)); unsigned v;
    asm volatile("v_mov_b32 %0, %1\n\tds_read_b32 %0, %0\n\ts_waitcnt lgkmcnt(0)" : "=&v"(v) : "s"(a) : "memory"); return (unsigned)__builtin_amdgcn_readfirstlane(v); }
__device__ __forceinline__ void xcd_local_barrier(const XcdBarrier& b) {
    asm volatile("s_waitcnt vmcnt(0)" ::: "memory");
    __syncthreads();
    if (threadIdx.x == 0) {
        unsigned* bar = b.bar;
        __builtin_amdgcn_s_waitcnt(0);
        const unsigned nloc = b.st[0];
        const unsigned old = xb_add(&bar[XB_XSUB(b.x)], 1u);
        const unsigned gen = old / nloc;
        if (old + 1u == (gen + 1u) * nloc) xb_add(&bar[XB_XGEN(b.x)], 1u);
        else XB_SPIN(xb_ld(&bar[XB_XGEN(b.x)]) == gen, bar);
        __builtin_amdgcn_fence(__ATOMIC_ACQUIRE, "agent");
        asm volatile("s_waitcnt vmcnt(0)" ::: "memory");
    }
    __syncthreads();
}

namespace dsa {
constexpr size_t SLAB_EL = 4194304;
constexpr int PA = 3072, QOFF = 0, KOFF = 1024, VOFF = 1088, QIOFF = 1152, KIOFF = 1664;
constexpr int SEQ = 4096, SC_STRIDE = 4096, LDS_SC = 0, LDS_IDX = 131072, LDS_DUMMY = 135680, TOPK = 256;
typedef short bf16x8 __attribute__((ext_vector_type(8)));
typedef short s16x4 __attribute__((ext_vector_type(4)));
typedef float f32x16 __attribute__((ext_vector_type(16)));
typedef float f32x4 __attribute__((ext_vector_type(4)));
typedef unsigned u32x4 __attribute__((ext_vector_type(4)));
typedef unsigned u32x2 __attribute__((ext_vector_type(2)));
typedef float f32x2 __attribute__((ext_vector_type(2)));
typedef unsigned short bf16_t;
#define DSA_LAS __attribute__((address_space(3)))
__device__ __forceinline__ unsigned cvtpk(float lo, float hi) { unsigned r; asm volatile("v_cvt_pk_bf16_f32 %0, %1, %2" : "=v"(r) : "v"(lo), "v"(hi)); return r; }
__device__ __forceinline__ float relu1(float x) { return __builtin_amdgcn_fmed3f(x, 0.0f, __builtin_inff()); }
__device__ __forceinline__ int mbcnt64(unsigned long long m) { return (int)__builtin_amdgcn_mbcnt_hi((unsigned)(m >> 32), __builtin_amdgcn_mbcnt_lo((unsigned)m, 0u)); }
__device__ __forceinline__ s16x4 trrd(DSA_LAS const unsigned char* p) { typedef short v4i16_t __attribute__((ext_vector_type(4))); return __builtin_bit_cast(s16x4, __builtin_amdgcn_ds_read_tr16_b64_v4i16((DSA_LAS v4i16_t*)p)); }
__device__ __forceinline__ int dpp_scan_add(int x) {
    x += __builtin_amdgcn_update_dpp(0, x, 0x111, 0xf, 0xf, false);
    x += __builtin_amdgcn_update_dpp(0, x, 0x112, 0xf, 0xf, false);
    x += __builtin_amdgcn_update_dpp(0, x, 0x114, 0xf, 0xf, false);
    x += __builtin_amdgcn_update_dpp(0, x, 0x118, 0xf, 0xf, false);
    x += __builtin_amdgcn_update_dpp(0, x, 0x142, 0xa, 0xf, false);
    x += __builtin_amdgcn_update_dpp(0, x, 0x143, 0xc, 0xf, false);
    return x;
}
__device__ __forceinline__ int wave_total(int x) { return __builtin_amdgcn_readlane(dpp_scan_add(x), 63); }
__device__ __forceinline__ float dpp_max_all(float x) {
    const int NI = (int)0xff800000u;
#define DSA_MX(ctrl, rm) x = __builtin_fmaxf(x, __builtin_bit_cast(float, __builtin_amdgcn_update_dpp(NI, __builtin_bit_cast(int, x), ctrl, rm, 0xf, false)))
    DSA_MX(0x111, 0xf); DSA_MX(0x112, 0xf); DSA_MX(0x114, 0xf); DSA_MX(0x118, 0xf); DSA_MX(0x142, 0xa); DSA_MX(0x143, 0xc);
#undef DSA_MX
    return __builtin_bit_cast(float, __builtin_amdgcn_readlane(__builtin_bit_cast(int, x), 63));
}
__device__ __forceinline__ void glds16(const void* gsrc, unsigned lds_dst) { unsigned keep;
    asm volatile("s_mov_b32 %0, m0\n\ts_mov_b32 m0, %2\n\ts_nop 0\n\tglobal_load_lds_dwordx4 %1, off\n\ts_mov_b32 m0, %0" : "=&s"(keep) : "v"(gsrc), "s"(lds_dst) : "memory"); }

constexpr int IDX_D = 4;
struct IdxQ { bf16x8 A[2][4]; float w[2][16]; };
__device__ __forceinline__ void index_load_q(IdxQ& q, const bf16_t* __restrict__ P, const float* __restrict__ WI, long rowbase, int t0, int lane) {
    const int r = lane & 31, h8 = lane >> 5;
    const int tok = 2 * ((r >> 2) & 1) + (r >> 4), head = 4 * ((r >> 3) & 1) + (r & 3);
#pragma unroll
    for (int rt = 0; rt < 2; ++rt) {
        const bf16_t* qp = P + (size_t)(rowbase + t0 + 4 * rt + tok) * PA + QIOFF + head * 64 + 8 * h8;
#pragma unroll
        for (int s = 0; s < 4; ++s) q.A[rt][s] = *(const bf16x8*)(qp + 16 * s);
#pragma unroll
        for (int qq = 0; qq < 2; ++qq) { const float* wp = WI + (size_t)(rowbase + t0 + 4 * rt + 2 * h8 + qq) * 8; const f32x4 wa = *(const f32x4*)wp, wb = *(const f32x4*)(wp + 4);
#pragma unroll
            for (int i = 0; i < 4; ++i) { q.w[rt][8 * qq + i] = wa[i]; q.w[rt][8 * qq + 4 + i] = wb[i]; } }
    }
}
__device__ __forceinline__ void index_unit(DSA_LAS unsigned char* lds, const bf16_t* __restrict__ P, const bf16_t* __restrict__ KIT, const float* __restrict__ WI, bf16_t* __restrict__ IDXG, int b, int t0, int nb, int nt0, IdxQ& Q, int wid, int lane) {
    const long rowbase = (long)b * SEQ;
    DSA_LAS float* SC = (DSA_LAS float*)(lds + LDS_SC);
    DSA_LAS unsigned short* myidx = (DSA_LAS unsigned short*)(lds + LDS_IDX) + wid * TOPK;
    {
        const int r = lane & 31, h8 = lane >> 5;
        const int ntile = (t0 + 8 + 31) >> 5;
        const bf16_t* kbase = KIT + (size_t)b * SLAB_EL + lane * 8;
        bf16x8 Bw[IDX_D][4];
#pragma unroll
        for (int i = 0; i < IDX_D; ++i) { int kt = wid + 8 * i; kt = kt < ntile ? kt : ntile - 1;
#pragma unroll
            for (int s = 0; s < 4; ++s) Bw[i][s] = *(const bf16x8*)(kbase + (size_t)(kt * 4 + s) * 512); }
        for (int base = 0; wid + 8 * base < ntile; base += IDX_D) {
#pragma unroll
            for (int i = 0; i < IDX_D; ++i) { const int kt = wid + 8 * (base + i);
                if (kt < ntile) {
                    f32x16 acc[2];
#pragma unroll
                    for (int rt = 0; rt < 2; ++rt) { acc[rt] = (f32x16){0.f, 0.f, 0.f, 0.f, 0.f, 0.f, 0.f, 0.f, 0.f, 0.f, 0.f, 0.f, 0.f, 0.f, 0.f, 0.f};
#pragma unroll
                        for (int s = 0; s < 4; ++s) acc[rt] = __builtin_amdgcn_mfma_f32_32x32x16_bf16(Q.A[rt][s], Bw[i][s], acc[rt], 0, 0, 0); }
                    { int ktn = kt + 8 * IDX_D; ktn = ktn < ntile ? ktn : ntile - 1;
#pragma unroll
                      for (int s = 0; s < 4; ++s) Bw[i][s] = *(const bf16x8*)(kbase + (size_t)(ktn * 4 + s) * 512); }
#pragma unroll
                    for (int rt = 0; rt < 2; ++rt) { float s0 = 0.f, s1 = 0.f;
#pragma unroll
                        for (int e = 0; e < 8; ++e) { s0 += Q.w[rt][e] * relu1(acc[rt][e]); s1 += Q.w[rt][8 + e] * relu1(acc[rt][8 + e]); }
                        SC[(4 * rt + 2 * h8 + 0) * SC_STRIDE + 32 * kt + r] = s0;
                        SC[(4 * rt + 2 * h8 + 1) * SC_STRIDE + 32 * kt + r] = s1; }
                } }
        }
        index_load_q(Q, P, WI, (long)nb * SEQ, nt0, lane);
    }
    __syncthreads();
    const int t = t0 + wid, n = t + 1;
    const float NINF = -__builtin_inff(), PINF = __builtin_inff();
    int lk = lane; asm volatile("" : "+v"(lk));
    f32x2 vp[32];
#define V(j) vp[(j) >> 1][(j) & 1]
#pragma unroll
    for (int j = 0; j < 32; ++j) vp[j] = (f32x2){NINF, NINF};
    if (n > TOPK) {
        const DSA_LAS float* row = SC + wid * SC_STRIDE;
#pragma unroll
        for (int g = 0; g < 8; ++g) if (512 * g < n) {
#pragma unroll
            for (int j = 8 * g; j < 8 * g + 8; ++j) { const int key = 64 * j + lk; const float x = row[key]; V(j) = (key < n) ? x : NINF; } }
    }
    asm volatile("s_waitcnt lgkmcnt(0)" ::: "memory");
    __syncthreads();
    bf16_t* gl = IDXG + (size_t)b * SLAB_EL + (size_t)t * TOPK;
    if (n <= TOPK) {
        u32x2 o; o.x = (unsigned)(4 * lane) | ((unsigned)(4 * lane + 1) << 16); o.y = (unsigned)(4 * lane + 2) | ((unsigned)(4 * lane + 3) << 16);
        *(u32x2*)(gl + 4 * lane) = o;
    } else {
        float mx = NINF, nmn = NINF;
#pragma unroll
        for (int j = 0; j < 64; ++j) { mx = __builtin_fmaxf(mx, V(j)); nmn = __builtin_fmaxf(nmn, (V(j) == NINF) ? NINF : -V(j)); }
        mx = dpp_max_all(mx); const float mn = -dpp_max_all(nmn);
        DSA_LAS unsigned short* dummy = (DSA_LAS unsigned short*)(lds + LDS_DUMMY) + wid * 64 + lane;
        const int ng = (n + 511) >> 9;
#define DSA_GROUPS(BODY) switch (ng) { default: BODY(7) case 7: BODY(6) case 6: BODY(5) case 5: BODY(4) case 4: BODY(3) case 3: BODY(2) case 2: BODY(1) case 1: BODY(0) }
#define DSA_EMIT_CNT(g_) { _Pragma("unroll") for (int j_ = 8 * (g_); j_ < 8 * (g_) + 8; ++j_) cl_ += (DSA_PRED(V(j_), T)) ? 1 : 0; }
#define DSA_EMIT_WR(g_) { _Pragma("unroll") for (int j_ = 8 * (g_); j_ < 8 * (g_) + 8; ++j_) { const bool sel_ = DSA_PRED(V(j_), Tw_); \
                DSA_LAS unsigned short* dst_ = sel_ ? (myidx + (pos_ & (TOPK - 1))) : dummy; *dst_ = (unsigned short)(64 * j_ + lk); pos_ += sel_ ? 1 : 0; } }
#define DSA_EMIT(OKV) do { int cl_ = 0; DSA_GROUPS(DSA_EMIT_CNT) \
            int pos_ = dpp_scan_add(cl_); OKV = (__builtin_amdgcn_readlane(pos_, 63) == TOPK); pos_ -= cl_; asm volatile("" : "+v"(pos_)); \
            if (OKV) { float Tw_ = T; asm volatile("" : "+v"(Tw_));     \
                DSA_GROUPS(DSA_EMIT_WR) } } while (0)
#define DSA_CMP8(OP, g_) { unsigned long long m0_, m1_, m2_, m3_, m4_, m5_, m6_, m7_; \
            asm volatile("v_cmp_" OP "_f32_e64 %0, %8, %16\n\tv_cmp_" OP "_f32_e64 %1, %9, %16\n\tv_cmp_" OP "_f32_e64 %2, %10, %16\n\tv_cmp_" OP "_f32_e64 %3, %11, %16\n\t" \
                         "v_cmp_" OP "_f32_e64 %4, %12, %16\n\tv_cmp_" OP "_f32_e64 %5, %13, %16\n\tv_cmp_" OP "_f32_e64 %6, %14, %16\n\tv_cmp_" OP "_f32_e64 %7, %15, %16" \
                         : "=s"(m0_), "=s"(m1_), "=s"(m2_), "=s"(m3_), "=s"(m4_), "=s"(m5_), "=s"(m6_), "=s"(m7_) \
                         : "v"(V(8 * (g_))), "v"(V(8 * (g_) + 1)), "v"(V(8 * (g_) + 2)), "v"(V(8 * (g_) + 3)), "v"(V(8 * (g_) + 4)), "v"(V(8 * (g_) + 5)), "v"(V(8 * (g_) + 6)), "v"(V(8 * (g_) + 7)), "v"(xx_)); \
            c_ += (__builtin_popcountll(m0_) + __builtin_popcountll(m1_)) + (__builtin_popcountll(m2_) + __builtin_popcountll(m3_)) + (__builtin_popcountll(m4_) + __builtin_popcountll(m5_)) + (__builtin_popcountll(m6_) + __builtin_popcountll(m7_)); }
#define DSA_CGE_GRP(g_) DSA_CMP8("ge", g_)
#define DSA_CGT_GRP(g_) DSA_CMP8("gt", g_)
#define DSA_COUNT_GE(X, C) do { int c_ = 0; const float xx_ = (X); DSA_GROUPS(DSA_CGE_GRP) C = c_; } while (0)
#define DSA_COUNT_GT(X, C) do { int c_ = 0; const float xx_ = (X); DSA_GROUPS(DSA_CGT_GRP) C = c_; } while (0)
        float lo, hi, T = 0.f; int c_lo, c_hi, c_gt = 0; bool tie = false, found = false;
        { int c0, cp; DSA_COUNT_GE(0.0f, c0); DSA_COUNT_GT(0.0f, cp);
          if (cp < TOPK && c0 >= TOPK) { T = 0.f; tie = true; c_gt = cp; found = true; }
          else if (cp >= TOPK) { lo = 0.f; c_lo = c0; hi = mx; c_hi = 1; }
          else { lo = mn; c_lo = n; hi = 0.f; c_hi = c0 > 0 ? c0 : 1; } }
        if (!found) {
            for (int it = 0;; ++it) {
                float x;
                if ((it % 3) == 2) x = 0.5f * lo + 0.5f * hi;
                else { const float llo = __builtin_amdgcn_logf((float)c_lo), lhi = __builtin_amdgcn_logf((float)c_hi); float tt = (llo - 8.0f) / (llo - lhi + 1e-6f); tt = __builtin_fminf(__builtin_fmaxf(tt, 0.03f), 0.97f); x = lo + (hi - lo) * tt; }
                if (!(x > lo && x < hi)) { x = 0.5f * lo + 0.5f * hi; if (!(x > lo && x < hi)) { T = lo; tie = true; DSA_COUNT_GT(T, c_gt); break; } }
                int c; DSA_COUNT_GE(x, c);
                if (c == TOPK) { T = x; tie = false; break; }
                if (c > TOPK) { lo = x; c_lo = c; } else { hi = x; c_hi = c > 0 ? c : 1; }
            }
        }
#undef DSA_COUNT_GT
#undef DSA_CGT_GRP
#undef DSA_CMP8
#undef DSA_COUNT_GE
#undef DSA_CGE_GRP
        bool done = false;
        if (!tie) {
#define DSA_PRED(val, thr) ((val) >= (thr))
            DSA_EMIT(done);
#undef DSA_PRED
        }
        if (!done) {
            int base = 0, eqbase = 0; const int need_eq = TOPK - c_gt;
#pragma unroll
            for (int j = 0; j < 64; ++j) {
                const bool gt = V(j) > T, eq = V(j) == T; const unsigned long long me = __builtin_amdgcn_ballot_w64(eq); const int rk = eqbase + mbcnt64(me); eqbase += __builtin_popcountll(me);
                const bool sel = gt || (eq && rk < need_eq);
                const unsigned long long m = __builtin_amdgcn_ballot_w64(sel); const int pos = base + mbcnt64(m);
                if (sel && pos < TOPK) myidx[pos] = (unsigned short)(64 * j + lk);
                base += __builtin_popcountll(m);
            }
        }
#undef DSA_EMIT
#undef DSA_EMIT_CNT
#undef DSA_EMIT_WR
#undef DSA_GROUPS
        asm volatile("s_waitcnt lgkmcnt(0)" ::: "memory");
        const u32x2 o = *(const DSA_LAS u32x2*)(myidx + 4 * lane);
        *(u32x2*)(gl + 4 * lane) = o;
    }
#undef V
}

__device__ __forceinline__ void index_phase(DSA_LAS unsigned char* lds, const bf16_t* P, const bf16_t* KIT, const float* WI, bf16_t* IDXG, int vcu, int G, int wid, int lane) {
#define DSA_UNIT_OF(I, B_, U_, OK_) do { if (G == 256) { OK_ = (I) < 16; const int k_ = 15 - ((I) < 16 ? (I) : 15), r_ = vcu & 31; B_ = vcu >> 5; U_ = 32 * k_ + ((k_ & 1) ? (31 - r_) : r_); } \
        else { const int ug_ = vcu + (I) * G; OK_ = ug_ < 8 * 512; const int uc_ = OK_ ? ug_ : vcu; B_ = uc_ >> 9; U_ = uc_ & 511; } } while (0)
    int b, u; bool ok; DSA_UNIT_OF(0, b, u, ok);
    IdxQ Q;
    if (ok) index_load_q(Q, P, WI, (long)b * SEQ, 8 * u, lane);
    for (int i = 0; ok; ++i) {
        int nb, nu; bool nok; DSA_UNIT_OF(i + 1, nb, nu, nok);
        if (!nok) { nb = b; nu = u; }
        index_unit(lds, P, KIT, WI, IDXG, b, 8 * u, nb, 8 * nu, Q, wid, lane);
        b = nb; u = nu; ok = nok;
    }
#undef DSA_UNIT_OF
    __syncthreads();
}

constexpr int LDS_LI2 = 136704, LDS_KT = 140800;
constexpr int LDS_LI2_UNUSED_ = 0;
__device__ __forceinline__ void glds16s(const void* sbase, unsigned voff, unsigned lds_dst) { unsigned keep;
    asm volatile("s_mov_b32 %0, m0\n\ts_mov_b32 m0, %2\n\ts_nop 0\n\tglobal_load_lds_dwordx4 %1, %3\n\ts_mov_b32 m0, %0" : "=&s"(keep) : "v"(voff), "s"(lds_dst), "s"(sbase) : "memory"); }
__device__ __forceinline__ void attn_phase(DSA_LAS unsigned char* lds, const bf16_t* __restrict__ P, const bf16_t* __restrict__ KV, const bf16_t* __restrict__ IDXG, bf16_t* __restrict__ O, int vcu, int G, int wid, int lane_in) {
    DSA_LAS unsigned char* vimg = lds + LDS_SC + wid * 16384;
    DSA_LAS unsigned short* liA = (DSA_LAS unsigned short*)(lds + LDS_IDX) + wid * TOPK;
    DSA_LAS unsigned short* liB = (DSA_LAS unsigned short*)(lds + LDS_LI2) + wid * TOPK;
    const unsigned vaddr = (unsigned)(unsigned long long)vimg;
    const int nrows = 8 * SEQ;
    const bool blocked = (nrows % (G * 8)) == 0;
    const int nq = blocked ? nrows / (G * 8) : (nrows - (vcu * 8 + wid) + G * 8 - 1) / (G * 8);
    const int row0 = blocked ? (vcu * 8 + wid) * nq : vcu * 8 + wid, rstep = blocked ? 1 : G * 8;
    if (nq <= 0) return;
    int lane = lane_in;
#define DSA_LOFF(R_) ((size_t)((R_) >> 12) * SLAB_EL + (size_t)((R_) & (SEQ - 1)) * TOPK)
#define DSA_KGATHER(LI, ROW) do { const char* kvb_ = (const char*)(KV + (size_t)((ROW) >> 12) * SLAB_EL); DSA_LAS const unsigned short* lik_ = (LI) + (lane >> 3); const unsigned kc_ = (unsigned)((lane & 7) * 16); \
        _Pragma("unroll") for (int kt = 0; kt < 16; ++kt) { K0[kt] = *(const bf16x8*)(kvb_ + ((unsigned)lik_[16 * kt] * 256u + kc_)); K1[kt] = *(const bf16x8*)(kvb_ + ((unsigned)lik_[16 * kt + 8] * 256u + kc_)); } } while (0)
#define DSA_VCHUNK(LI, ROW, C, BOFF) do { const char* kvb_ = (const char*)(KV + (size_t)((ROW) >> 12) * SLAB_EL); DSA_LAS const unsigned short* liv_ = (LI) + (lane >> 3); \
        _Pragma("unroll") for (int i_ = 0; i_ < 8; ++i_) glds16s(kvb_, (unsigned)liv_[64 * (C) + 8 * i_] * 256u + vsw, (unsigned)__builtin_amdgcn_readfirstlane(vaddr + (BOFF) + i_ * 1024)); } while (0)
#define DSA_PV(C, BOFF) do { _Pragma("unroll") for (int k2_ = 0; k2_ < 2; ++k2_) { const bf16x8 PF_ = __builtin_bit_cast(bf16x8, pw[2 * (C) + k2_]); \
        _Pragma("unroll") for (int nd = 0; nd < 4; ++nd) { const s16x4 vlo_ = trrd(vb[nd] + (BOFF) + k2_ * 4096); const s16x4 vhi_ = trrd(vb[nd] + (BOFF) + k2_ * 4096 + 2048); \
            const bf16x8 VF_ = (bf16x8){vlo_[0], vlo_[1], vlo_[2], vlo_[3], vhi_[0], vhi_[1], vhi_[2], vhi_[3]}; o[nd] = __builtin_amdgcn_mfma_f32_16x16x32_bf16(PF_, VF_, o[nd], 0, 0, 0); } } } while (0)
    bf16x8 K0[16], K1[16];
    u32x2 nl;
    { const int c16 = lane & 15, g4 = lane >> 4; const unsigned vsw = 128u + (unsigned)(((lane & 7) ^ (((lane >> 4) & 3) << 1)) * 16);
      *(DSA_LAS u32x2*)(liA + 4 * lane) = *(const u32x2*)(IDXG + DSA_LOFF(row0) + 4 * lane);
      asm volatile("s_waitcnt vmcnt(0) lgkmcnt(0)" ::: "memory");
      DSA_VCHUNK(liA, row0, 0, 0); DSA_VCHUNK(liA, row0, 1, 8192);
      DSA_KGATHER(liA, row0);
      nl = *(const u32x2*)(IDXG + DSA_LOFF(nq > 1 ? row0 + rstep : row0) + 4 * lane); }
    for (int i = 0; i < nq; ++i) {
        const int row = row0 + i * rstep; const bool has_next = (i + 1 < nq); const int nrow = has_next ? row + rstep : row;
        DSA_LAS unsigned short* li = (i & 1) ? liB : liA; DSA_LAS unsigned short* lin = (i & 1) ? liA : liB;
        { int lq_ = lane; asm volatile("" : "+v"(lq_)); lane = lq_; }
        const int c16 = lane & 15, g4 = lane >> 4;
        const unsigned vsw = 128u + (unsigned)(((lane & 7) ^ (((lane >> 4) & 3) << 1)) * 16);
        const int t = row & (SEQ - 1); const int cntq = (t + 1 < TOPK) ? t + 1 : TOPK;
        *(DSA_LAS u32x2*)(lin + 4 * lane) = nl;
        { const int n2 = (i + 2 < nq) ? row + 2 * rstep : row; nl = *(const u32x2*)(IDXG + DSA_LOFF(n2) + 4 * lane); }
        const char* qb = (const char*)(P + (size_t)row * PA + QOFF); const unsigned qoff = (unsigned)(c16 * 128 + g4 * 16);
        const bf16x8 Q0 = *(const bf16x8*)(qb + qoff), Q1 = *(const bf16x8*)(qb + qoff + 64);
        f32x4 st[16];
        { DSA_LAS unsigned char* ksc = lds + LDS_KT + wid * 2048;
          const int wr_ = (lane >> 3) * 128 + (((lane & 7) ^ ((lane >> 4) & 7)) * 16);
          const int rd_ = c16 * 128 + ((g4 ^ ((c16 >> 1) & 7)) * 16), rd1_ = c16 * 128 + (((4 + g4) ^ ((c16 >> 1) & 7)) * 16);
          *(DSA_LAS bf16x8*)(ksc + wr_) = K0[0]; *(DSA_LAS bf16x8*)(ksc + 1024 + (wr_ ^ 64)) = K1[0];
          bf16x8 A0 = *(const DSA_LAS bf16x8*)(ksc + rd_), A1 = *(const DSA_LAS bf16x8*)(ksc + rd1_);
#pragma unroll
          for (int kt = 0; kt < 16; ++kt) {
              bf16x8 B0 = A0, B1 = A1;
              if (kt + 1 < 16) { *(DSA_LAS bf16x8*)(ksc + wr_) = K0[kt + 1]; *(DSA_LAS bf16x8*)(ksc + 1024 + (wr_ ^ 64)) = K1[kt + 1];
                                 B0 = *(const DSA_LAS bf16x8*)(ksc + rd_); B1 = *(const DSA_LAS bf16x8*)(ksc + rd1_); }
              __builtin_amdgcn_sched_barrier(0);
              f32x4 a = {0.f, 0.f, 0.f, 0.f};
              a = __builtin_amdgcn_mfma_f32_16x16x32_bf16(A0, Q0, a, 0, 0, 0);
              a = __builtin_amdgcn_mfma_f32_16x16x32_bf16(A1, Q1, a, 0, 0, 0);
              st[kt] = a; A0 = B0; A1 = B1;
              __builtin_amdgcn_sched_barrier(0); } }
        if (cntq < TOPK) { int g4m = g4; asm volatile("" : "+v"(g4m));
#pragma unroll
            for (int kt = 0; kt < 16; ++kt)
#pragma unroll
                for (int r = 0; r < 4; ++r) if (16 * kt + 4 * g4m + r >= cntq) st[kt][r] = -__builtin_inff(); }
        float m = -__builtin_inff();
#pragma unroll
        for (int kt = 0; kt < 16; ++kt) m = __builtin_fmaxf(m, __builtin_fmaxf(__builtin_fmaxf(st[kt][0], st[kt][1]), __builtin_fmaxf(st[kt][2], st[kt][3])));
        m = __builtin_fmaxf(m, __shfl_xor(m, 16)); m = __builtin_fmaxf(m, __shfl_xor(m, 32));
        float lsum = 0.f;
#pragma unroll
        for (int kt = 0; kt < 16; ++kt) { st[kt] = st[kt] - m;
#pragma unroll
            for (int r = 0; r < 4; ++r) { st[kt][r] = __builtin_amdgcn_exp2f(st[kt][r]); lsum += st[kt][r]; } }
        lsum += __shfl_xor(lsum, 16); lsum += __shfl_xor(lsum, 32);
        u32x4 pw[8];
#pragma unroll
        for (int ks = 0; ks < 8; ++ks) { pw[ks].x = cvtpk(st[2 * ks][0], st[2 * ks][1]); pw[ks].y = cvtpk(st[2 * ks][2], st[2 * ks][3]); pw[ks].z = cvtpk(st[2 * ks + 1][0], st[2 * ks + 1][1]); pw[ks].w = cvtpk(st[2 * ks + 1][2], st[2 * ks + 1][3]); }
        f32x4 o[4];
#pragma unroll
        for (int nd = 0; nd < 4; ++nd) o[nd] = (f32x4){0.f, 0.f, 0.f, 0.f};
        const int q_ = c16 >> 2, p_ = lane & 3, F2 = (2 * (g4 & 1) + (q_ >> 1)) << 1;
        DSA_LAS const unsigned char* vb[4];
#pragma unroll
        for (int nd = 0; nd < 4; ++nd) vb[nd] = vimg + (4 * g4 + q_) * 128 + (((2 * nd) ^ F2) + (p_ >> 1)) * 16 + (p_ & 1) * 8;
        asm volatile("s_waitcnt vmcnt(8)" ::: "memory");
        DSA_PV(0, 0);
        asm volatile("s_waitcnt lgkmcnt(0)" ::: "memory"); DSA_VCHUNK(li, row, 2, 0);
        asm volatile("s_waitcnt vmcnt(8)" ::: "memory");
        DSA_PV(1, 8192);
        asm volatile("s_waitcnt lgkmcnt(0)" ::: "memory"); DSA_VCHUNK(li, row, 3, 8192);
        if (has_next) { DSA_KGATHER(lin, nrow); asm volatile("s_waitcnt vmcnt(40)" ::: "memory"); }
        else asm volatile("s_waitcnt vmcnt(8)" ::: "memory");
        DSA_PV(2, 0);
        asm volatile("s_waitcnt lgkmcnt(0)" ::: "memory");
        if (has_next) { DSA_VCHUNK(lin, nrow, 0, 0); asm volatile("s_waitcnt vmcnt(40)" ::: "memory"); }
        else asm volatile("s_waitcnt vmcnt(0)" ::: "memory");
        DSA_PV(3, 8192);
        asm volatile("s_waitcnt lgkmcnt(0)" ::: "memory");
        if (has_next) DSA_VCHUNK(lin, nrow, 1, 8192);
        const float linv = 1.0f / lsum;
        bf16_t* op = O + (size_t)row * 1024 + (4 * g4) * 64 + c16;
#pragma unroll
        for (int r = 0; r < 4; ++r) { const float lv = __shfl(linv, 4 * g4 + r);
#pragma unroll
            for (int nd = 0; nd < 4; ++nd) { const unsigned pk = cvtpk(o[nd][r] * lv, 0.f); op[r * 64 + 16 * nd] = (bf16_t)(pk & 0xffffu); } }
    }
#undef DSA_KGATHER
#undef DSA_LOFF
#undef DSA_VCHUNK
#undef DSA_PV
}
#undef DSA_LAS
}

constexpr int NWAVES = 8;
constexpr int NB = 8, SEQ = 4096, D = 1024, FF = 2752, FFP = 2816, NGU = 5632, DEPTH = 4;
constexpr int M = NB * SEQ;
constexpr int A_IN = 1736, A_INP = 1792, B_IN = 3072;
constexpr float EPS = 1e-6f;
constexpr float QSCALE = 0.125f * 1.4426950408889634f;
constexpr float WISCALE = 0.04419417382415922f;
constexpr size_t MiB = 1u << 20;
constexpr size_t WS_CTL = 0, CTL_ZERO_BYTES = 1 * MiB;
constexpr size_t WS_MOD = 2 * MiB;
constexpr size_t WS_ROPE = 4 * MiB;
constexpr size_t WS_WI = 6 * MiB;
constexpr size_t WS_W = 8 * MiB;
constexpr size_t W_FFN_STRIDE = 17301504, W_D_OFF = 11534336;
constexpr size_t W_DSA = WS_W + 8 * W_FFN_STRIDE, W_DSA_STRIDE = 5767168, W_DSA_OUT_OFF = 3670016;
constexpr size_t W_DIFF = W_DSA + 2 * W_DSA_STRIDE, W_DIFF_STRIDE = 8 * MiB, W_DIFF_OUT_OFF = 6 * MiB;
constexpr size_t WS_H = 168 * MiB;
constexpr size_t WS_Y = 232 * MiB;
constexpr size_t WS_BIG = 296 * MiB;
constexpr size_t WS_XB = 488 * MiB;
constexpr size_t WS_END = 552 * MiB;
constexpr size_t WS_KIT = WS_Y, WS_KV = WS_Y + 1 * MiB, WS_IDXL = WS_Y + 2 * MiB;
constexpr int BIG_LD = 3072;
static_assert(BIG_LD == B_IN && BIG_LD >= FFP && BIG_LD >= A_INP && BIG_LD == dsa::PA && pg8::SLAB_EL * 2 * NB == 64 * MiB, "batch-private layouts");
static_assert(W_DIFF + 2 * W_DIFF_STRIDE <= WS_H && WS_Y == WS_H + 64 * MiB && WS_BIG == WS_Y + 64 * MiB && WS_BIG + (size_t)M * B_IN * 2 <= WS_XB && WS_XB + (size_t)M * D * 2 <= WS_END, "d_ws map");
constexpr int CW_BAR = 4096;
constexpr int RING_OFF = 0, RING_BYTES = 131072;
constexpr int IDX_OFF = RING_BYTES;
constexpr int LDSCTL_OFF = RING_BYTES + 4096, MISC_OFF = LDSCTL_OFF + 320;
constexpr int LDS_BYTES = 157184;
static_assert(MISC_OFF + 128 <= dsa::LDS_DUMMY && dsa::LDS_DUMMY + 1024 <= dsa::LDS_LI2 && dsa::LDS_LI2 + 4096 <= dsa::LDS_KT && dsa::LDS_KT + 8 * 2048 <= LDS_BYTES && dsa::LDS_IDX == IDX_OFF, "LDS map");

__device__ __forceinline__ float wave_sum(float v) {
#define WS_STEP(ctrl, rm) v += __builtin_bit_cast(float, __builtin_amdgcn_update_dpp(0, __builtin_bit_cast(int, v), ctrl, rm, 0xf, false))
    WS_STEP(0x111, 0xf); WS_STEP(0x112, 0xf); WS_STEP(0x114, 0xf); WS_STEP(0x118, 0xf); WS_STEP(0x142, 0xa); WS_STEP(0x143, 0xc);
#undef WS_STEP
    return __builtin_bit_cast(float, __builtin_amdgcn_readlane(__builtin_bit_cast(int, v), 63));
}
__device__ __forceinline__ int rope_perm16(int p) { return (p < 8) ? ((p & 1) ? 8 + (p >> 1) : (p >> 1)) : ((p & 1) ? 12 + ((p - 8) >> 1) : 4 + ((p - 8) >> 1)); }
__device__ __forceinline__ void tr_item(const float* W, int ldw, int Ksrc, int ncols, bf16* WT, int ldt, int k0, int d0, int col0, bool perm, LAS float* scr, int lane) {
    const int c4 = lane & 7, kr = lane >> 3, colb = col0 + 4 * c4;
    const bool cok = (col0 >= 0) && (colb < ncols);
    f32x4 tv[8];
#pragma unroll
    for (int i = 0; i < 8; ++i) { const int k = k0 + 8 * i + kr; tv[i] = (cok && k < Ksrc) ? *(const f32x4*)(W + (size_t)k * ldw + colb) : (f32x4){0.f, 0.f, 0.f, 0.f}; }
#pragma unroll
    for (int i = 0; i < 8; ++i) { LAS float* p = scr + (8 * i + kr) * 33 + 4 * c4; p[0] = tv[i].x; p[1] = tv[i].y; p[2] = tv[i].z; p[3] = tv[i].w; }
    LDS_WAIT(); asm volatile("" ::: "memory");
    const int c = lane & 7;
#pragma unroll
    for (int j = 0; j < 4; ++j) { const int n = (lane >> 3) + 8 * j; const int pn = (perm && n < 16) ? rope_perm16(n) : n;
        const LAS float* s = scr + (8 * c) * 33 + pn;
        v4u o; o.x = pk2(s[0 * 33], s[1 * 33]); o.y = pk2(s[2 * 33], s[3 * 33]); o.z = pk2(s[4 * 33], s[5 * 33]); o.w = pk2(s[6 * 33], s[7 * 33]);
        *(GAS v4u*)(WT + (size_t)(d0 + n) * ldt + k0 + 8 * c) = o; }
    LDS_WAIT(); asm volatile("" ::: "memory");
}

using pg8::pk4_fp8;
__device__ __forceinline__ void tr_item8(const float* W, int ldw, int Ksrc, int ncols, unsigned char* WT8, int ldt, int k0, int d0, int col0, float scale, LAS float* scr, int lane, bool perm = false) {
    const int c4 = lane & 7, kr = lane >> 3, colb = col0 + 4 * c4;
    const bool cok = (col0 >= 0) && (colb < ncols);
    f32x4 tv[8];
#pragma unroll
    for (int i = 0; i < 8; ++i) { const int k = k0 + 8 * i + kr; tv[i] = (cok && k < Ksrc) ? *(const f32x4*)(W + (size_t)k * ldw + colb) : (f32x4){0.f, 0.f, 0.f, 0.f}; }
#pragma unroll
    for (int i = 0; i < 8; ++i) { LAS float* p = scr + (8 * i + kr) * 33 + 4 * c4; p[0] = tv[i].x * scale; p[1] = tv[i].y * scale; p[2] = tv[i].z * scale; p[3] = tv[i].w * scale; }
    LDS_WAIT(); asm volatile("" ::: "memory");
    const int c = lane & 7;
#pragma unroll
    for (int j = 0; j < 4; ++j) { const int n = (lane >> 3) + 8 * j; const int pn = (perm && n < 16) ? rope_perm16(n) : n;
        const LAS float* s = scr + (8 * c) * 33 + pn;
        typedef unsigned v2u_ __attribute__((ext_vector_type(2)));
        v2u_ o; o.x = pk4_fp8(s[0 * 33], s[1 * 33], s[2 * 33], s[3 * 33]); o.y = pk4_fp8(s[4 * 33], s[5 * 33], s[6 * 33], s[7 * 33]);
        *(GAS v2u_*)(WT8 + (size_t)(d0 + n) * ldt + k0 + 8 * c) = o; }
    LDS_WAIT(); asm volatile("" ::: "memory");
}

struct Args { const float* in[16]; float* out; unsigned char* ws; };

typedef const __attribute__((address_space(4))) Args* kargs_t0;
__device__ __forceinline__ void p0_prologue(kargs_t0 ap, LAS unsigned char* lds, int tid, int lane, int wave, int vcu, int G) {
    unsigned char* ws = ap->ws;
    if (vcu < 144) {
        LAS float* cond = (LAS float*)lds;
        LAS float* red = (LAS float*)(lds + 32768);
        const float* cin = ap->in[1];
        for (int i = tid; i < 8 * 1024; i += NWAVES * 64) { const float x = cin[i]; cond[i] = x / (1.0f + __expf(-x)); }
        __syncthreads();
        const int l = vcu / 36, n0 = (vcu % 36) * 256;
        const float* Wl = ap->in[3] + (size_t)l * 1024 * 9216 + n0 + 4 * lane;
        f32x4 acc[8];
#pragma unroll
        for (int b = 0; b < 8; ++b) acc[b] = (f32x4){0.f, 0.f, 0.f, 0.f};
        for (int kb = 0; kb < 128; kb += 8) { f32x4 wv[8];
#pragma unroll
            for (int u = 0; u < 8; ++u) wv[u] = *(const f32x4*)(Wl + (size_t)(128 * wave + kb + u) * 9216);
#pragma unroll
            for (int u = 0; u < 8; ++u) { const int k = 128 * wave + kb + u;
#pragma unroll
                for (int b = 0; b < 8; ++b) acc[b] += wv[u] * cond[b * 1024 + k]; } }
#pragma unroll
        for (int b = 0; b < 8; ++b) *(LAS f32x4*)(red + (wave * 8 + b) * 256 + 4 * lane) = acc[b];
        __syncthreads();
        { const int o = tid * 4, b = o >> 8, col = o & 255; f32x4 s = *(const f32x4*)(ap->in[4] + (size_t)l * 9216 + n0 + col);
#pragma unroll
          for (int w = 0; w < 8; ++w) s += *(LAS f32x4*)(red + (w * 8 + b) * 256 + col);
          *(f32x4*)((float*)(ws + WS_MOD) + ((size_t)l * 8 + b) * 9216 + n0 + col) = s; }
        __syncthreads();
    }
    { const int* pos = (const int*)ap->in[2]; float* tab = (float*)(ws + WS_ROPE);
      for (int i = vcu * (NWAVES * 64) + tid; i < M * 8; i += G * NWAVES * 64) { const int row = i >> 3, j = i & 7;
          const float inv = (j == 0) ? 1.0f : (j == 1) ? 0.19392274474868576f : (j == 2) ? 0.03760603093086393f : (j == 3) ? 0.007292664737217109f : (j == 4) ? 0.001414213562373095f : (j == 5) ? 0.0002742481756762073f : (j == 6) ? 5.318295896944988e-05f : 1.031338537721246e-05f;
          const float ang = (float)pos[row] * inv;
          const double rev = (double)ang * 0.15915494309189535; const float fr = (float)(rev - __builtin_rint(rev));
          tab[(size_t)row * 16 + j] = __builtin_amdgcn_cosf(fr); tab[(size_t)row * 16 + 8 + j] = __builtin_amdgcn_sinf(fr); } }
    LAS float* scr = (LAS float*)(lds + wave * 16384);
    const int gw = vcu * NWAVES + wave, NGW = G * NWAVES;
    constexpr int I_GU = 16 * 176, I_D = 44 * 32, I_FFN = I_GU + I_D, I_AIN = 16 * 56, I_O = 16 * 32, I_DSA = I_AIN + I_O, I_BIN = 16 * 96, I_DIFF = I_BIN + I_O;
    constexpr int NITEMS = 8 * I_FFN + 2 * I_DSA + 2 * I_DIFF;
    const int nmw = (G > 144) ? (G - 144) * NWAVES : 0; const int X = (nmw * 16 < NITEMS) ? nmw * 16 : NITEMS;
    const int w1 = (vcu - 144) * NWAVES + wave; const int n1 = (vcu >= 144 && w1 < X) ? (X - w1 + nmw - 1) / nmw : 0;
    for (int k = 0;; ++k) {
        const int it = (k < n1) ? w1 + k * nmw : X + gw + (k - n1) * NGW; if (it >= NITEMS) break;
        int r = it;
        if (r < 8 * I_FFN) { const int f = r / I_FFN; r -= f * I_FFN;
            if (r < I_GU) { const int kb = r / 176, nb = r % 176, d0 = 32 * nb, p = d0 >> 8, w0 = d0 & 255; const bool up = w0 >= 128;
                const float* W = (up ? ap->in[8] : ap->in[7]) + (size_t)f * 1024 * FF;
                tr_item8(W, FF, 1024, FF, ws + WS_W + f * W_FFN_STRIDE, 1024, 64 * kb, d0, 128 * p + (w0 & 127), 64.0f, scr, lane); }
            else { r -= I_GU; const int kb = r / 32, nb = r % 32;
                tr_item8(ap->in[9] + (size_t)f * FF * 1024, 1024, FF, 1024, ws + WS_W + f * W_FFN_STRIDE + W_D_OFF, FFP, 64 * kb, 32 * nb, 32 * nb, 64.0f, scr, lane); }
            continue; }
        r -= 8 * I_FFN;
        if (r < 2 * I_DSA) { const int j = r / I_DSA; r -= j * I_DSA;
            if (r < I_AIN) { const int kb = r / 56, nb = r % 56, d0 = 32 * nb; const bool perm = (d0 < 1728) && !(d0 >= 1088 && d0 < 1152) && ((d0 & 63) == 0);
                tr_item(ap->in[10] + (size_t)j * 1024 * A_IN, A_IN, 1024, A_IN, (bf16*)(ws + W_DSA + j * W_DSA_STRIDE), 1024, 64 * kb, d0, d0, perm, scr, lane); }
            else { r -= I_AIN; const int kb = r / 32, nb = r % 32;
                tr_item(ap->in[11] + (size_t)j * 1024 * 1024, 1024, 1024, 1024, (bf16*)(ws + W_DSA + j * W_DSA_STRIDE + W_DSA_OUT_OFF), 1024, 64 * kb, 32 * nb, 32 * nb, false, scr, lane); }
            continue; }
        r -= 2 * I_DSA;
        { const int j = r / I_DIFF; r -= j * I_DIFF;
            if (r < I_BIN) { const int kb = r / 96, nb = r % 96, d0 = 32 * nb; const bool perm = (d0 < 2048) && ((d0 & 63) == 0);
                tr_item8(ap->in[12] + (size_t)j * 1024 * B_IN, B_IN, 1024, B_IN, ws + W_DIFF + j * W_DIFF_STRIDE, 1024, 64 * kb, d0, d0, 64.0f, scr, lane, perm); }
            else { r -= I_BIN; const int kb = r / 32, nb = r % 32;
                tr_item(ap->in[13] + (size_t)j * 1024 * 1024, 1024, 1024, 1024, (bf16*)(ws + W_DIFF + j * W_DIFF_STRIDE + W_DIFF_OUT_OFF), 1024, 64 * kb, 32 * nb, 32 * nb, false, scr, lane); }
        }
    }
}

template <bool HAS_Y, bool HAS_H, bool XIN32, bool XOUT32, bool H8 = false>
__device__ __forceinline__ void thin_phase(int gw, int NGW, int lane, const bf16* Y, const void* XIN, void* XOUT, bf16* HOUT,
                                           const float* gate, const float* pn, float coef, const float* pre, const float* sc, const float* sh, bool poison) {
#define TP_UNPK(q, lo, hi) do { lo = (f32x4){__builtin_bit_cast(float, q.x << 16), __builtin_bit_cast(float, q.x & 0xffff0000u), __builtin_bit_cast(float, q.y << 16), __builtin_bit_cast(float, q.y & 0xffff0000u)}; \
                                hi = (f32x4){__builtin_bit_cast(float, q.z << 16), __builtin_bit_cast(float, q.z & 0xffff0000u), __builtin_bit_cast(float, q.w << 16), __builtin_bit_cast(float, q.w & 0xffff0000u)}; } while (0)
#define TP_PK(lo, hi) (v4u){pk2(lo.x, lo.y), pk2(lo.z, lo.w), pk2(hi.x, hi.y), pk2(hi.z, hi.w)}
    for (int ch = gw; ch < M / 16; ch += NGW) {
        const int b = ch >> 8;
        f32x4 a1[4], a2[4], a3[4];
#pragma unroll
        for (int k = 0; k < 4; ++k) { const int col = 512 * (k >> 1) + 8 * lane + 4 * (k & 1);
            if (HAS_Y) a1[k] = *(const f32x4*)(gate + (size_t)b * 9216 + col) * *(const f32x4*)(pn + col) * coef;
            if (HAS_H) { a2[k] = *(const f32x4*)(pre + col) * (*(const f32x4*)(sc + (size_t)b * 9216 + col) + 1.0f); a3[k] = *(const f32x4*)(sh + (size_t)b * 9216 + col); } }
#pragma unroll 2
        for (int r = 0; r < 16; ++r) { const size_t row = (size_t)ch * 16 + r;
            f32x4 xv[4];
#pragma unroll
            for (int j = 0; j < 2; ++j) { const size_t off = row * D + 512 * j + 8 * lane;
                if (XIN32) { xv[2 * j] = *(const f32x4*)((const float*)XIN + off); xv[2 * j + 1] = *(const f32x4*)((const float*)XIN + off + 4); }
                else { const v4u q = __builtin_nontemporal_load((const v4u*)((const bf16*)XIN + off)); TP_UNPK(q, xv[2 * j], xv[2 * j + 1]); } }
            if (HAS_Y) { f32x4 yv[4]; float ss = 0.f;
#pragma unroll
                for (int j = 0; j < 2; ++j) { const v4u q = __builtin_nontemporal_load((const v4u*)(Y + row * D + 512 * j + 8 * lane)); TP_UNPK(q, yv[2 * j], yv[2 * j + 1]); }
#pragma unroll
                for (int k = 0; k < 4; ++k) ss += (yv[k].x * yv[k].x + yv[k].y * yv[k].y) + (yv[k].z * yv[k].z + yv[k].w * yv[k].w);
                const float rs = 1.0f / sqrtf(wave_sum(ss) * (1.0f / D) + EPS);
                const float qn = __builtin_nanf("");
#pragma unroll
                for (int k = 0; k < 4; ++k) xv[k] = xv[k] + a1[k] * yv[k] * rs;
#pragma unroll
                for (int j = 0; j < 2; ++j) { const size_t off = row * D + 512 * j + 8 * lane;
                    if (XOUT32) { *(f32x4*)((float*)XOUT + off) = poison ? (f32x4){qn, qn, qn, qn} : xv[2 * j]; *(f32x4*)((float*)XOUT + off + 4) = poison ? (f32x4){qn, qn, qn, qn} : xv[2 * j + 1]; }
                    else __builtin_nontemporal_store(TP_PK(xv[2 * j], xv[2 * j + 1]), (v4u*)((bf16*)XOUT + off)); } }
            else if (!XOUT32 && XOUT != nullptr) {
#pragma unroll
                for (int j = 0; j < 2; ++j) *(v4u*)((bf16*)XOUT + row * D + 512 * j + 8 * lane) = TP_PK(xv[2 * j], xv[2 * j + 1]); }
            if (HAS_H) { float s2 = 0.f;
#pragma unroll
                for (int k = 0; k < 4; ++k) s2 += (xv[k].x * xv[k].x + xv[k].y * xv[k].y) + (xv[k].z * xv[k].z + xv[k].w * xv[k].w);
                const float r2 = 1.0f / sqrtf(wave_sum(s2) * (1.0f / D) + EPS);
                f32x4 hv[4];
#pragma unroll
                for (int k = 0; k < 4; ++k) hv[k] = xv[k] * r2 * a2[k] + a3[k];
#pragma unroll
                for (int j = 0; j < 2; ++j) {
                    if (H8) { typedef unsigned v2u_ __attribute__((ext_vector_type(2))); const f32x4 p = hv[2 * j] * 16.0f, q2 = hv[2 * j + 1] * 16.0f;
                        v2u_ o; o.x = pk4_fp8(p.x, p.y, p.z, p.w); o.y = pk4_fp8(q2.x, q2.y, q2.z, q2.w); *(v2u_*)((unsigned char*)HOUT + row * (2 * D) + 512 * j + 8 * lane) = o; }
                    else *(v4u*)(HOUT + row * D + 512 * j + 8 * lane) = TP_PK(hv[2 * j], hv[2 * j + 1]); } }
        }
    }
#undef TP_UNPK
#undef TP_PK
}

typedef const __attribute__((address_space(4))) Args* kargs_t;
__device__ __forceinline__ kargs_t kargs_ptr() { kargs_t p = (kargs_t)__builtin_amdgcn_kernarg_segment_ptr(); asm volatile("" : "+s"(p)); return p; }
#define KARGS() const kargs_t A_ = kargs_ptr(); unsigned char* const ws = A_->ws; (void)ws
#define GRID_BAR() do { XcdBarrier bar_; { KARGS(); bar_.bar = (unsigned*)(ws + WS_CTL) + CW_BAR; } bar_.x = xb_xcc_id(); bar_.st = (volatile LAS unsigned*)(lds + MISC_OFF) + 8; if (lds_word_uniform((unsigned)(unsigned long long)(lds + MISC_OFF + 44)) != 0u) xcd_local_barrier(bar_); else xcd_barrier(bar_); } while (0)
#define VCU_G() int G_l = gridDim.x, bx_l = blockIdx.x; asm volatile("" : "+s"(bx_l)); { const unsigned m_ = lds_word_uniform((unsigned)(unsigned long long)(lds + MISC_OFF + 44)); int sel_; asm volatile("s_cmp_lg_u32 %1, 0\n\ts_cselect_b32 %0, %2, %3" : "=s"(sel_) : "s"(m_), "s"(m_ - 1u), "s"(bx_l) : "scc"); bx_l = sel_; } asm volatile("" : "+s"(G_l), "+s"(bx_l)); const int G = G_l; const int vcu = (G % 8 == 0) ? (bx_l % 8) * (G / 8) + bx_l / 8 : bx_l; (void)vcu
#define WAVE_IDS() int tid_l = threadIdx.x; asm volatile("" : "+v"(tid_l)); const int tid = tid_l, lane = tid & 63, wave = __builtin_amdgcn_readfirstlane(tid >> 6); (void)lane; (void)wave

__device__ __forceinline__ void ffn_block(LAS unsigned char* lds, int L, int S, bool first) {
    const int f_ = L * 2 + S;
    { KARGS(); VCU_G(); pg8::Gemm g{(const bf16*)(ws + WS_H), (const bf16*)(ws + WS_W + f_ * W_FFN_STRIDE), M, NGU, D / 2, D}; pg8::StaticOrder So; So.init(M, NGU, G, bx_l);
      pg8::EpiSwiGLU<true> E{(bf16*)(ws + WS_BIG), BIG_LD}; pg8::gemm_phase<pg8::EpiSwiGLU<true>, pg8::StaticOrder, true, true, true>(lds + RING_OFF, g, So, E); }
    GRID_BAR();
    { KARGS(); VCU_G(); pg8::Gemm g{(const bf16*)(ws + WS_BIG), (const bf16*)(ws + WS_W + f_ * W_FFN_STRIDE + W_D_OFF), M, D, FFP / 2, BIG_LD}; pg8::StaticOrder So; So.init(M, D, G, bx_l);
      pg8::EpiBf16<0> E{(bf16*)(ws + WS_Y), D}; pg8::gemm_phase<pg8::EpiBf16<0>, pg8::StaticOrder, true, true, true>(lds + RING_OFF, g, So, E); }
    GRID_BAR();
    { KARGS(); VCU_G(); WAVE_IDS(); const int gw = vcu * NWAVES + wave, NGW = G * NWAVES;
      const int k_ = S ? 2 : 0; const int ln_ = S ? L + 1 : L, kn_ = S ? 0 : 1;
      const float* mod = (const float*)(ws + WS_MOD); const float* pre_norm = A_->in[5]; const float* post_norm = A_->in[6];
      const bool poison_ = (__hip_atomic_load((gu32*)(ws + WS_CTL) + CW_BAR + XB_TMO, RLX_AGENT) != 0u);
      if (ln_ < DEPTH && (S || (L & 1))) thin_phase<true, true, false, false, true>(gw, NGW, lane, (const bf16*)(ws + WS_Y), ws + WS_XB, ws + WS_XB, (bf16*)(ws + WS_H), mod + (size_t)L * 73728 + (3 * k_ + 2) * 1024, post_norm + (L * 3 + k_) * 1024, 0.5f,
                            pre_norm + (ln_ * 3 + kn_) * 1024, mod + (size_t)ln_ * 73728 + (3 * kn_ + 1) * 1024, mod + (size_t)ln_ * 73728 + (3 * kn_) * 1024, poison_);
      else if (ln_ < DEPTH) thin_phase<true, true, false, false>(gw, NGW, lane, (const bf16*)(ws + WS_Y), ws + WS_XB, ws + WS_XB, (bf16*)(ws + WS_H), mod + (size_t)L * 73728 + (3 * k_ + 2) * 1024, post_norm + (L * 3 + k_) * 1024, 0.5f,
                            pre_norm + (ln_ * 3 + kn_) * 1024, mod + (size_t)ln_ * 73728 + (3 * kn_ + 1) * 1024, mod + (size_t)ln_ * 73728 + (3 * kn_) * 1024, poison_);
      else thin_phase<true, false, false, true>(gw, NGW, lane, (const bf16*)(ws + WS_Y), ws + WS_XB, A_->out, nullptr, mod + (size_t)L * 73728 + (3 * k_ + 2) * 1024, post_norm + (L * 3 + k_) * 1024, 0.5f, nullptr, nullptr, nullptr, poison_); }
    GRID_BAR();
}
__device__ __forceinline__ void mix_tail(LAS unsigned char* lds, int L, size_t a_off, size_t w_off) {
    { KARGS(); VCU_G(); pg8::Gemm g{(const bf16*)(ws + a_off), (const bf16*)(ws + w_off), M, D, D, D}; pg8::StaticOrder So; So.init(M, D, G, bx_l);
      pg8::EpiBf16<0> E{(bf16*)(ws + WS_Y), D}; pg8::gemm_phase<pg8::EpiBf16<0>, pg8::StaticOrder, true, true>(lds + RING_OFF, g, So, E); }
    GRID_BAR();
    { KARGS(); VCU_G(); WAVE_IDS(); const int gw = vcu * NWAVES + wave, NGW = G * NWAVES;
      const float* mod = (const float*)(ws + WS_MOD); const float* pre_norm = A_->in[5]; const float* post_norm = A_->in[6];
      thin_phase<true, true, false, false, true>(gw, NGW, lane, (const bf16*)(ws + WS_Y), ws + WS_XB, ws + WS_XB, (bf16*)(ws + WS_H), mod + (size_t)L * 73728 + 5 * 1024, post_norm + (L * 3 + 1) * 1024, 1.0f,
                             pre_norm + (L * 3 + 2) * 1024, mod + (size_t)L * 73728 + 7 * 1024, mod + (size_t)L * 73728 + 6 * 1024, false); }
    GRID_BAR();
}

__global__ void __launch_bounds__(NWAVES * 64, 2) hybrid_fwd(Args args) {
    extern __shared__ __attribute__((aligned(16))) unsigned char lds_raw[];
    LAS unsigned char* lds = (LAS unsigned char*)lds_raw;
    { WAVE_IDS(); for (int u = tid; u < (LDS_BYTES - LDSCTL_OFF) / 4; u += NWAVES * 64) ((LAS unsigned*)(lds + LDSCTL_OFF))[u] = 0u; }
    __syncthreads();
    { KARGS(); (void)xcd_barrier_post((unsigned*)(ws + WS_CTL) + CW_BAR, (volatile LAS unsigned*)(lds + MISC_OFF) + 8); }

    { KARGS(); VCU_G(); WAVE_IDS(); p0_prologue(A_, lds, tid, lane, wave, vcu, G); }
    GRID_BAR();
    { KARGS(); VCU_G(); WAVE_IDS(); const float* mod = (const float*)(ws + WS_MOD);
      thin_phase<false, true, true, false, true>(vcu * NWAVES + wave, G * NWAVES, lane, nullptr, A_->in[0], ws + WS_XB, (bf16*)(ws + WS_H), nullptr, nullptr, 0.f, A_->in[5], mod + 1024, mod, false); }
    GRID_BAR();

    for (int j = 0; j < 2; ++j) {
        const int la = 2 * j, lb = 2 * j + 1;
        ffn_block(lds, la, 0, j == 0);
        { KARGS(); VCU_G(); pg8::Gemm g{(const bf16*)(ws + WS_H), (const bf16*)(ws + W_DSA + j * W_DSA_STRIDE), M, A_INP, D, D}; pg8::StaticOrder So; So.init(M, A_INP, G, bx_l);
          pg8::EpiProj E{(bf16*)(ws + WS_BIG), BIG_LD, (const float*)(ws + WS_ROPE), 1728, 1088, 1152, 1024, QSCALE, (float*)(ws + WS_WI), 1728, WISCALE, (bf16*)(ws + WS_KIT), 1664, (bf16*)(ws + WS_KV), 1024};
          pg8::gemm_phase<pg8::EpiProj, pg8::StaticOrder, true, true>(lds + RING_OFF, g, So, E); }
        GRID_BAR();
        { KARGS(); VCU_G(); WAVE_IDS(); dsa::index_phase(lds, (const bf16*)(ws + WS_BIG), (const bf16*)(ws + WS_KIT), (const float*)(ws + WS_WI), (bf16*)(ws + WS_IDXL), vcu, G, wave, lane); }
        GRID_BAR();
        { KARGS(); VCU_G(); WAVE_IDS(); dsa::attn_phase(lds, (const bf16*)(ws + WS_BIG), (const bf16*)(ws + WS_KV), (const bf16*)(ws + WS_IDXL), (bf16*)(ws + WS_H), vcu, G, wave, lane); }
        GRID_BAR();
        mix_tail(lds, la, WS_H, W_DSA + j * W_DSA_STRIDE + W_DSA_OUT_OFF);
        ffn_block(lds, la, 1, false);
        ffn_block(lds, lb, 0, false);
        { KARGS(); VCU_G(); pg8::Gemm g{(const bf16*)(ws + WS_H), (const bf16*)(ws + W_DIFF + j * W_DIFF_STRIDE), M, B_IN, D / 2, D}; pg8::StaticOrder So; So.init(M, B_IN, G, bx_l);
          pg8::EpiProj E{(bf16*)(ws + WS_BIG), B_IN, (const float*)(ws + WS_ROPE), 2048, 0, 0, 1024, QSCALE, nullptr, -1, 0.f, nullptr, -1000, nullptr, -1000};
          pg8::gemm_phase<pg8::EpiProj, pg8::StaticOrder, true, true, true>(lds + RING_OFF, g, So, E); }
        GRID_BAR();
        { KARGS(); VCU_G(); const attn_body::bf16* P = (const attn_body::bf16*)(ws + WS_BIG);
          const attn_body::AttnTensors AT{P, P + 1024, P + 2048, (attn_body::bf16*)(ws + WS_Y), (attn_body::bf16*)(ws + WS_H), A_->in[14] + j * 256, A_->in[15] + j * 128, lb};
          attn_body::attn_phase<8>((char*)lds_raw + RING_OFF, AT, vcu, G); }
        GRID_BAR();
        mix_tail(lds, lb, WS_H, W_DIFF + j * W_DIFF_STRIDE + W_DIFF_OUT_OFF);
        ffn_block(lds, lb, 1, false);
    }
}

extern "C" void kernel_launch(void* const* d_in, const int* in_sizes, int n_in, void* d_out, int out_size, void* d_ws, size_t ws_size, hipStream_t stream) {
    static int grid = 0;
    if (grid == 0) {
        if (n_in != 16 || out_size != M * D || ws_size < WS_END) { fprintf(stderr, "kernel_launch: unexpected shapes (n_in %d, out %d, ws %zu); nothing launched\n", n_in, out_size, ws_size); grid = -1; return; }
        int dev = 0, cus = 0, per_cu = 0;
        if (hipGetDevice(&dev) != hipSuccess || hipDeviceGetAttribute(&cus, hipDeviceAttributeMultiprocessorCount, dev) != hipSuccess) { grid = -1; return; }
        if (hipFuncSetAttribute((const void*)hybrid_fwd, hipFuncAttributeMaxDynamicSharedMemorySize, LDS_BYTES) != hipSuccess) { fprintf(stderr, "kernel_launch: hipFuncSetAttribute failed\n"); grid = -1; return; }
        if (hipOccupancyMaxActiveBlocksPerMultiprocessor(&per_cu, (const void*)hybrid_fwd, NWAVES * 64, LDS_BYTES) != hipSuccess || per_cu < 1) { fprintf(stderr, "kernel_launch: occupancy query reports %d\n", per_cu); }
        (void)hipGetLastError();
        grid = cus;
    }
    if (grid < 0) return;
    if (hipMemsetAsync((char*)d_ws + WS_CTL, 0, CTL_ZERO_BYTES, stream) != hipSuccess) return;
    Args a{};
    for (int i = 0; i < 16; ++i) a.in[i] = (const float*)d_in[i];
    a.out = (float*)d_out; a.ws = (unsigned char*)d_ws;
    hipLaunchKernelGGL(hybrid_fwd, dim3(grid), dim3(NWAVES * 64), LDS_BYTES, stream, a);
}
```

```cpp
#include <hip/hip_runtime.h>
#include <hip/hip_bf16.h>
#include <cstdio>
#include <cstdint>
#include <cmath>
namespace pg8 {
#define PG8_LAS __attribute__((address_space(3)))
typedef unsigned short bf16_t;
typedef short bf16x8 __attribute__((ext_vector_type(8)));
typedef float f32x4 __attribute__((ext_vector_type(4)));
typedef unsigned u32x4 __attribute__((ext_vector_type(4)));
constexpr size_t SLAB_EL = 4194304;
constexpr int BM = 256, BK = 64, HALF = 128, HTB = HALF * BK * 2  , STAGE_BYTES = 8 * HTB, NXCD = 8, WGM = 8;

__host__ __device__ __forceinline__ int lds_byte(int r, int c) { const int st = (r >> 4) * 2 + (c >> 5), rr = r & 15, cc = c & 31, ob = rr * 64 + cc * 2; return st * 1024 + (ob ^ (((ob >> 9) & 1) << 5)); }
__host__ __device__ __forceinline__ void stage_rc(int b, int& R, int& C) { const int st = b / 1024, sb = b % 1024, swz = sb ^ (((sb >> 9) & 1) << 5); R = (st >> 1) * 16 + swz / 64; C = (st & 1) * 32 + (swz % 64) / 2; }
__host__ __device__ __forceinline__ int perm32(int rho) { const int n = rho >> 4, i = rho & 15; return 8 * (i >> 2) + 4 * n + (i & 3); }

struct Unit { int pm, pn; };
struct Gemm { const bf16_t* A; const bf16_t* Bt; int M, N, K, lda; };

struct StaticOrder {
    int nM, nN, nwg, G, c;
    __host__ __device__ void init(int M, int N, int G_, int c_) { nM = M / BM; nN = N / BM; nwg = nM * nN; G = G_; c = c_; }
    __host__ __device__ bool next(int i, Unit& u) const {
        const long L = (long)i * G + c; if (L >= nwg) return false;
        int wgid = (int)L; { const int q = nwg / NXCD, r = nwg % NXCD, xcd = wgid % NXCD, off = wgid / NXCD; wgid = (xcd < r ? xcd * (q + 1) : r * (q + 1) + (xcd - r) * q) + off; }
        const int nig = WGM * nN, gid = wgid / nig, fm = gid * WGM, gsz = (nM - fm) < WGM ? (nM - fm) : WGM;
        u.pm = fm + ((wgid % nig) % gsz); u.pn = (wgid % nig) / gsz; return true;
    }
    __device__ __forceinline__ void a_ready(const Unit&) const {}
    __device__ __forceinline__ void done(const Unit&) const {}
};

__device__ __forceinline__ unsigned cvt_pk_bf16(float lo, float hi) { unsigned r; asm volatile("v_cvt_pk_bf16_f32 %0, %1, %2" : "=v"(r) : "v"(lo), "v"(hi)); return r; }
typedef float f32x2 __attribute__((ext_vector_type(2)));
template <int ACT> struct EpiBf16 {
    static constexpr bool PERM = true, AFTER_DRAIN = false;
    bf16_t* O; int ldc;
    __device__ __forceinline__ void operator()(const f32x4 (&acc)[2][2][4][2], const Unit& u, int wr, int wc, int fr, int fq) const {
        const int row0 = u.pm * BM + wr * 64 + fr; const int col0 = u.pn * BM + wc * 32 + 8 * fq;
#pragma unroll
        for (int ai = 0; ai < 2; ++ai)
#pragma unroll
            for (int m = 0; m < 4; ++m) { bf16_t* rowp = O + (size_t)(row0 + ai * HALF + m * 16) * ldc + col0;
#pragma unroll
                for (int bj = 0; bj < 2; ++bj) { const f32x4 v0 = acc[ai][bj][m][0], v1 = acc[ai][bj][m][1];
                    u32x4 w; w.x = cvt_pk_bf16(v0[0], v0[1]); w.y = cvt_pk_bf16(v0[2], v0[3]); w.z = cvt_pk_bf16(v1[0], v1[1]); w.w = cvt_pk_bf16(v1[2], v1[3]);
                    *(u32x4*)(rowp + bj * HALF) = w; } }
    }
};

__device__ __forceinline__ unsigned pk4_fp8(float a, float b, float c, float d) { a = __builtin_amdgcn_fmed3f(a, -448.0f, 448.0f); b = __builtin_amdgcn_fmed3f(b, -448.0f, 448.0f); c = __builtin_amdgcn_fmed3f(c, -448.0f, 448.0f); d = __builtin_amdgcn_fmed3f(d, -448.0f, 448.0f);
    int o = 0; o = __builtin_amdgcn_cvt_pk_fp8_f32(a, b, o, false); o = __builtin_amdgcn_cvt_pk_fp8_f32(c, d, o, true); return (unsigned)o; }
template <bool O8> struct EpiSwiGLU {
    static constexpr bool PERM = true, AFTER_DRAIN = false;
    bf16_t* O; int ldc;
    __device__ __forceinline__ static float sg(float g, float u) { const float e = __builtin_amdgcn_exp2f(g * -1.4426950408889634f); return g * u * __builtin_amdgcn_rcpf(1.0f + e); }
    __device__ __forceinline__ void operator()(const f32x4 (&acc)[2][2][4][2], const Unit& u, int wr, int wc, int fr, int fq) const {
        const int row0 = u.pm * BM + wr * 64 + fr; const int col0 = u.pn * HALF + wc * 32 + 8 * fq;
#pragma unroll
        for (int ai = 0; ai < 2; ++ai)
#pragma unroll
            for (int m = 0; m < 4; ++m) { bf16_t* rowp = O + (size_t)(row0 + ai * HALF + m * 16) * ldc + col0;
                const f32x4 g0 = acc[ai][0][m][0], g1 = acc[ai][0][m][1], u0 = acc[ai][1][m][0], u1 = acc[ai][1][m][1];
                if constexpr (O8) { typedef unsigned v2u_ __attribute__((ext_vector_type(2))); v2u_ w;
#define SG2(GV, UV, I) ({ const f32x2 g_ = {GV[I], GV[I + 1]}, u_ = {UV[I], UV[I + 1]}; const f32x2 t_ = g_ * -1.4426950408889634f; f32x2 e_; e_.x = __builtin_amdgcn_exp2f(t_.x); e_.y = __builtin_amdgcn_exp2f(t_.y); \
                          const f32x2 d_ = e_ + 1.0f; f32x2 r_; r_.x = __builtin_amdgcn_rcpf(d_.x); r_.y = __builtin_amdgcn_rcpf(d_.y); (g_ * (u_ * 16.0f)) * r_; })
                    { const f32x2 a_ = SG2(g0, u0, 0), b_ = SG2(g0, u0, 2), c_ = SG2(g1, u1, 0), d2_ = SG2(g1, u1, 2); w.x = pk4_fp8(a_.x, a_.y, b_.x, b_.y); w.y = pk4_fp8(c_.x, c_.y, d2_.x, d2_.y); }
#undef SG2
                    *(v2u_*)((unsigned char*)(O + (size_t)(row0 + ai * HALF + m * 16) * ldc) + col0) = w; }
                else { u32x4 w; w.x = cvt_pk_bf16(sg(g0[0], u0[0]), sg(g0[1], u0[1])); w.y = cvt_pk_bf16(sg(g0[2], u0[2]), sg(g0[3], u0[3]));
                w.z = cvt_pk_bf16(sg(g1[0], u1[0]), sg(g1[1], u1[1])); w.w = cvt_pk_bf16(sg(g1[2], u1[2]), sg(g1[3], u1[3]));
                *(u32x4*)rowp = w; } }
    }
};

struct EpiProj {
    static constexpr bool PERM = true, AFTER_DRAIN = false;
    bf16_t* O; int ldc; const float* rope; int rope_end, nr_lo, nr_hi, qs_end; float qscale; float* wi; int wi_col; float wscale;
    bf16_t* kit; int ki_lo;
    bf16_t* kv; int kv_lo;
    __device__ __forceinline__ void operator()(const f32x4 (&acc)[2][2][4][2], const Unit& u, int wr, int wc, int fr, int fq) const {
        const int row0 = u.pm * BM + wr * 64 + fr;
#pragma unroll
        for (int bj = 0; bj < 2; ++bj) {
            const int c8 = u.pn * BM + bj * HALF + wc * 32 + 8 * fq;
            const bool do_rope = (c8 < rope_end) && !(c8 >= nr_lo && c8 < nr_hi) && ((c8 & 63) < 16);
            const float sc = (c8 < qs_end) ? qscale : 1.0f;
            const int j0 = 4 * ((c8 >> 3) & 1);
            const bool do_wi = (c8 == wi_col);
            const bool do_kit = (c8 >= ki_lo && c8 < ki_lo + 64), do_kv = (c8 >= kv_lo && c8 < kv_lo + 128);
            const int kd = c8 - ki_lo;
#pragma unroll
            for (int ai = 0; ai < 2; ++ai)
#pragma unroll
                for (int m = 0; m < 4; ++m) { const int row = row0 + ai * HALF + m * 16;
                    f32x4 v0 = acc[ai][bj][m][0], v1 = acc[ai][bj][m][1];
                    if (do_rope) { const f32x4 cs = *(const f32x4*)(rope + (size_t)row * 16 + j0), sn = *(const f32x4*)(rope + (size_t)row * 16 + 8 + j0);
                        const f32x4 a0 = v0, a1 = v1;
                        v0[0] = a0[0] * cs[0] - a0[1] * sn[0]; v0[1] = a0[1] * cs[0] + a0[0] * sn[0];
                        v0[2] = a0[2] * cs[1] - a0[3] * sn[1]; v0[3] = a0[3] * cs[1] + a0[2] * sn[1];
                        v1[0] = a1[0] * cs[2] - a1[1] * sn[2]; v1[1] = a1[1] * cs[2] + a1[0] * sn[2];
                        v1[2] = a1[2] * cs[3] - a1[3] * sn[3]; v1[3] = a1[3] * cs[3] + a1[2] * sn[3]; }
                    v0 = v0 * sc; v1 = v1 * sc;
                    if (do_wi) { *(f32x4*)(wi + (size_t)row * 8) = v0 * wscale; *(f32x4*)(wi + (size_t)row * 8 + 4) = v1 * wscale; }
                    u32x4 w; w.x = cvt_pk_bf16(v0[0], v0[1]); w.y = cvt_pk_bf16(v0[2], v0[3]); w.z = cvt_pk_bf16(v1[0], v1[1]); w.w = cvt_pk_bf16(v1[2], v1[3]);
                    *(u32x4*)(O + (size_t)row * ldc + c8) = w;
                    if (do_kit) *(u32x4*)(kit + (size_t)(row >> 12) * (SLAB_EL - 262144) + ((size_t)(row >> 5) * 4 + (kd >> 4)) * 512 + (((kd >> 3) & 1) * 32 + (row & 31)) * 8) = w;
                    if (do_kv) *(u32x4*)(kv + (size_t)(row >> 12) * (SLAB_EL - 524288) + (size_t)row * 128 + (c8 - kv_lo)) = w; }
        }
    }
};

constexpr int F8_SA = 127 - 4, F8_SB = 127 - 6;
typedef int v8i32 __attribute__((ext_vector_type(8))); typedef int v4i32 __attribute__((ext_vector_type(4)));
template <class Epi, class Sched, bool ALIGN_EPI = false, bool SP2 = false, bool F8 = false>
__device__ __forceinline__ void gemm_phase(PG8_LAS unsigned char* lds, const Gemm g, const Sched& S, const Epi& E) {
    int tid_l = threadIdx.x; asm volatile("" : "+v"(tid_l));
    const int tid = tid_l, wid = __builtin_amdgcn_readfirstlane(tid >> 6), lane = tid & 63, wr = wid >> 2, wc = wid & 3, fr = lane & 15, fq = lane >> 4;
    const int K = g.K, nt = K / BK, lda = g.lda;
    unsigned voffA[2], voffB[2];
#pragma unroll
    for (int i = 0; i < 2; ++i) { int R, C; stage_rc(tid * 16 + i * 8192, R, C); const int Rb = Epi::PERM ? ((R & ~31) + perm32(R & 31)) : R;
        voffA[i] = (unsigned)(R * lda + C) * 2u; voffB[i] = (unsigned)(Rb * K + C) * 2u; }
    const size_t kstep = (size_t)(BK * 2);
    const size_t hstep = (size_t)HALF * K * 2;
    const size_t tstep = 2 * hstep;
    const size_t hstepA = (size_t)HALF * lda * 2, tstepA = 2 * hstepA;
    const unsigned ldsw = (unsigned)wid * 1024u;
    const int aoff = lds_byte(wr * 64 + fr, fq * 8), boff = lds_byte(wc * 32 + fr, fq * 8);
#define PG8_SA(b, h) (((b) * 2 + (h)) * HTB)
#define PG8_SB(b, h) ((4 + (b) * 2 + (h)) * HTB)
#define PG8_STAGE(bufoff, gbase, voff) do { _Pragma("unroll") for (int _i = 0; _i < 2; ++_i) \
        __builtin_amdgcn_global_load_lds((const unsigned*)((const char*)(gbase) + (voff)[_i]), (PG8_LAS unsigned*)(lds + (bufoff) + ldsw + _i * 8192), 16, 0, 0); } while (0)
#define PG8_CAT8(X) __builtin_shufflevector(__builtin_bit_cast(v4i32, X[0]), __builtin_bit_cast(v4i32, X[1]), 0, 1, 2, 3, 4, 5, 6, 7)
#define PG8_LDA(dst, b, h) do { _Pragma("unroll") for (int m = 0; m < 4; ++m) { _Pragma("unroll") for (int k = 0; k < 2; ++k) dst[m][k] = *(const PG8_LAS bf16x8*)(lds + PG8_SA(b, h) + aoff + m * 2048 + k * 1024); if constexpr (F8) dst##8[m] = PG8_CAT8(dst[m]); } } while (0)
#define PG8_LDB(dst, b, h) do { _Pragma("unroll") for (int n = 0; n < 2; ++n) { _Pragma("unroll") for (int k = 0; k < 2; ++k) dst[n][k] = *(const PG8_LAS bf16x8*)(lds + PG8_SB(b, h) + boff + n * 2048 + k * 1024); if constexpr (F8) dst##8[n] = PG8_CAT8(dst[n]); } } while (0)
#define PG8_MMA(ai, bj, At, Bt) do { __builtin_amdgcn_s_setprio(1); \
        if constexpr (F8) { _Pragma("unroll") for (int m = 0; m < 4; ++m) _Pragma("unroll") for (int n = 0; n < 2; ++n) \
            asm volatile("v_mfma_scale_f32_16x16x128_f8f6f4 %0, %1, %2, %0, %3, %4 op_sel_hi:[0,0,0]" : "+v"(acc[ai][bj][m][n]) : "v"(Bt##8[n]), "v"(At##8[m]), "v"(f8sb), "v"(f8sa)); }     \
        else { _Pragma("unroll") for (int m = 0; m < 4; ++m) _Pragma("unroll") for (int n = 0; n < 2; ++n) _Pragma("unroll") for (int k = 0; k < 2; ++k) \
            acc[ai][bj][m][n] = __builtin_amdgcn_mfma_f32_16x16x32_bf16(Bt[n][k], At[m][k], acc[ai][bj][m][n], 0, 0, 0); } \
        __builtin_amdgcn_s_setprio(0); } while (0)
#define PG8_WAIT_V(n) asm volatile("s_waitcnt vmcnt(" #n ")" ::: "memory")
#define PG8_WAIT_L(n) asm volatile("s_waitcnt lgkmcnt(" #n ")" ::: "memory")
#define PG8_BAR __builtin_amdgcn_s_barrier()
#define PG8_SCHED __builtin_amdgcn_sched_barrier(0)
    Unit cur, nxt; int ui = 0;
    if (!S.next(0, cur)) return;
    f32x4 acc[2][2][4][2];
#pragma unroll
    for (int a = 0; a < 2; ++a)
#pragma unroll
        for (int b = 0; b < 2; ++b)
#pragma unroll
            for (int m = 0; m < 4; ++m)
#pragma unroll
                for (int n = 0; n < 2; ++n) acc[a][b][m][n] = (f32x4){0.f, 0.f, 0.f, 0.f};
    const int f8sa = F8_SA, f8sb = F8_SB;
    bf16x8 At[4][2], B0[2][2], B1[2][2]; v8i32 At8[4], B08[2], B18[2];
    const char* cA = (const char*)g.A + (size_t)cur.pm * tstepA; const char* cB = (const char*)g.Bt + (size_t)cur.pn * tstep;
    S.a_ready(cur);
    if constexpr (SP2) {
        PG8_STAGE(PG8_SB(0, 0), cB, voffB); PG8_STAGE(PG8_SB(0, 1), cB + hstep, voffB); PG8_STAGE(PG8_SA(0, 0), cA, voffA); PG8_STAGE(PG8_SA(0, 1), cA + hstepA, voffA);
        if (wr == 1) PG8_BAR;
        PG8_WAIT_V(2); PG8_BAR;
        PG8_STAGE(PG8_SB(1, 0), cB + kstep, voffB); PG8_STAGE(PG8_SA(1, 0), cA + kstep, voffA); PG8_STAGE(PG8_SB(1, 1), cB + hstep + kstep, voffB);
        PG8_WAIT_V(6); PG8_BAR;
    } else {
        PG8_STAGE(PG8_SB(0, 0), cB, voffB); PG8_STAGE(PG8_SA(0, 0), cA, voffA); PG8_STAGE(PG8_SB(0, 1), cB + hstep, voffB); PG8_STAGE(PG8_SA(0, 1), cA + hstepA, voffA);
        if (wr == 1) PG8_BAR;
        PG8_WAIT_V(4); PG8_BAR;
        PG8_STAGE(PG8_SB(1, 0), cB + kstep, voffB); PG8_STAGE(PG8_SA(1, 0), cA + kstep, voffA); PG8_STAGE(PG8_SB(1, 1), cB + hstep + kstep, voffB);
        PG8_WAIT_V(6); PG8_BAR;
    }
    for (;;) {
        const bool has_next = S.next(ui + 1, nxt);
        const char* nA = has_next ? (const char*)g.A + (size_t)nxt.pm * tstepA : cA; const char* nB = has_next ? (const char*)g.Bt + (size_t)nxt.pn * tstep : cB;
        for (int t = 0; t < nt; t += 2) {
            const bool last = (t == nt - 2);
            const char* a1 = cA + (size_t)(t + 1) * kstep;
            const char* a2 = last ? nA : cA + (size_t)(t + 2) * kstep; const char* b2 = last ? nB : cB + (size_t)(t + 2) * kstep;
            const char* a3 = a2 + kstep; const char* b3 = b2 + kstep;
            if (last && has_next) S.a_ready(nxt);
            if constexpr (SP2) {
            PG8_LDB(B0, 0, 0); PG8_LDB(B1, 0, 1); PG8_SCHED; PG8_LDA(At, 0, 0); PG8_STAGE(PG8_SA(1, 1), a1 + hstepA, voffA);
            PG8_WAIT_V(8); PG8_WAIT_L(0); PG8_BAR; PG8_MMA(0, 0, At, B0); PG8_MMA(0, 1, At, B1); PG8_BAR; PG8_SCHED;
            PG8_LDA(At, 0, 1); PG8_STAGE(PG8_SB(0, 0), b2, voffB); PG8_STAGE(PG8_SB(0, 1), b2 + hstep, voffB); PG8_STAGE(PG8_SA(0, 0), a2, voffA);
            PG8_WAIT_V(8); PG8_WAIT_L(0); PG8_BAR; PG8_MMA(1, 0, At, B0); PG8_MMA(1, 1, At, B1); PG8_BAR; PG8_SCHED;
            PG8_LDB(B0, 1, 0); PG8_LDB(B1, 1, 1); PG8_SCHED; PG8_LDA(At, 1, 0); PG8_STAGE(PG8_SA(0, 1), a2 + hstepA, voffA);
            PG8_WAIT_V(8); PG8_WAIT_L(0); PG8_BAR; PG8_MMA(0, 0, At, B0); PG8_MMA(0, 1, At, B1); PG8_BAR; PG8_SCHED;
            PG8_LDA(At, 1, 1); PG8_STAGE(PG8_SB(1, 0), b3, voffB); PG8_STAGE(PG8_SB(1, 1), b3 + hstep, voffB); PG8_STAGE(PG8_SA(1, 0), a3, voffA);
            PG8_WAIT_V(8); PG8_WAIT_L(0); PG8_BAR; PG8_MMA(1, 0, At, B0); PG8_MMA(1, 1, At, B1); PG8_BAR; PG8_SCHED;
            } else {
            PG8_LDB(B0, 0, 0); PG8_SCHED; PG8_LDA(At, 0, 0); PG8_STAGE(PG8_SA(1, 1), a1 + hstepA, voffA);
            PG8_WAIT_L(8); PG8_BAR; PG8_WAIT_L(0); PG8_MMA(0, 0, At, B0); PG8_BAR; PG8_SCHED;
            PG8_LDB(B1, 0, 1); PG8_STAGE(PG8_SB(0, 0), b2, voffB);
            PG8_BAR; PG8_WAIT_L(0); PG8_MMA(0, 1, At, B1); PG8_BAR;
            PG8_LDA(At, 0, 1); PG8_STAGE(PG8_SA(0, 0), a2, voffA);
            PG8_BAR; PG8_WAIT_L(0); PG8_MMA(1, 0, At, B0); PG8_BAR; PG8_SCHED;
            PG8_STAGE(PG8_SB(0, 1), b2 + hstep, voffB);
            PG8_WAIT_V(6); PG8_BAR; PG8_MMA(1, 1, At, B1); PG8_BAR;
            PG8_LDB(B0, 1, 0); PG8_SCHED; PG8_LDA(At, 1, 0); PG8_STAGE(PG8_SA(0, 1), a2 + hstepA, voffA);
            PG8_WAIT_L(8); PG8_BAR; PG8_WAIT_L(0); PG8_MMA(0, 0, At, B0); PG8_BAR; PG8_SCHED;
            PG8_LDB(B1, 1, 1); PG8_STAGE(PG8_SB(1, 0), b3, voffB);
            PG8_BAR; PG8_WAIT_L(0); PG8_MMA(0, 1, At, B1); PG8_BAR;
            PG8_LDA(At, 1, 1); PG8_STAGE(PG8_SA(1, 0), a3, voffA);
            PG8_BAR; PG8_WAIT_L(0); PG8_MMA(1, 0, At, B0); PG8_BAR; PG8_SCHED;
            PG8_STAGE(PG8_SB(1, 1), b3 + hstep, voffB);
            PG8_WAIT_V(6); PG8_BAR; PG8_MMA(1, 1, At, B1); PG8_BAR;
            }
        }
        if constexpr (ALIGN_EPI) { if (wr == 0) PG8_BAR; }
        if constexpr (F8) asm volatile("s_nop 15\n\ts_nop 15\n\ts_nop 15" ::: "memory");
        if constexpr (!Epi::AFTER_DRAIN) { E(acc, cur, wr, wc, fr, fq); S.done(cur); }
        if (!has_next) break;
#pragma unroll
        for (int a = 0; a < 2; ++a)
#pragma unroll
            for (int b = 0; b < 2; ++b)
#pragma unroll
                for (int m = 0; m < 4; ++m)
#pragma unroll
                    for (int n = 0; n < 2; ++n) acc[a][b][m][n] = (f32x4){0.f, 0.f, 0.f, 0.f};
        cur = nxt; cA = nA; cB = nB; ++ui;
        if constexpr (ALIGN_EPI) { if (wr == 1) PG8_BAR; }
    }
    PG8_WAIT_V(0);
    if constexpr (!ALIGN_EPI) { if (wr == 0) PG8_BAR; }
    PG8_BAR;
    if constexpr (Epi::AFTER_DRAIN) { E.fused(acc, cur, wr, wc, fr, fq, lds, wid, lane); S.done(cur); }
#undef PG8_SA
#undef PG8_SB
#undef PG8_STAGE
#undef PG8_LDA
#undef PG8_LDB
#undef PG8_MMA
#undef PG8_CAT8
#undef PG8_WAIT_V
#undef PG8_WAIT_L
#undef PG8_BAR
#undef PG8_SCHED
}
}

namespace attn_body {
using bf16=__hip_bfloat16;
using bf16x8=__attribute__((ext_vector_type(8)))short;
using s16x4=__attribute__((ext_vector_type(4)))short;
using f32x16=__attribute__((ext_vector_type(16)))float;
using u32x4=__attribute__((ext_vector_type(4)))unsigned;
constexpr int BATCH=8,NCH=16,SEQ=4096,D=64,DV=128,QKVP=3072,OP=1024;
constexpr int NW=8,QBLK=32,QB=QBLK*NW,KVBLK=64,NQB=SEQ/QB;
constexpr int ATTN_UNIT_ROWS=QB;
__device__ __forceinline__ int crow(int r,int hi){return (r&3)+8*(r>>2)+4*hi;}
#define SBAR() __builtin_amdgcn_sched_barrier(0)
__device__ __forceinline__ void cmask(f32x16&p0,f32x16&p1,int jb,int qrel,int hi){
  const float NEG=-INFINITY; int kb=64*jb+4*hi;
  #pragma unroll
  for(int r=0;r<16;++r){int kv=kb+(r&3)+8*(r>>2); if(kv>qrel)p0[r]=NEG; if(kv+32>qrel)p1[r]=NEG;}
}

constexpr int NSLOT=3, SLOTB=8192, VSLOTB=2*SLOTB;
constexpr int LDS_K=0, LDS_V=NSLOT*SLOTB, LDS_WS=LDS_V+NSLOT*VSLOTB, LDS_BYTES=LDS_WS+NW*64*4+512, LDS_OST=0;
static_assert(NW*8192<=LDS_WS,"O stage inside the ring area");
constexpr float C2=0.125f*1.4426950408889634f;
__device__ __forceinline__ void glds16(const void*gsrc,unsigned lds_dst){unsigned keep;
  asm volatile("s_mov_b32 %0, m0\n\ts_mov_b32 m0, %2\n\ts_nop 0\n\tglobal_load_lds_dwordx4 %1, off\n\ts_mov_b32 m0, %0":"=&s"(keep):"v"(gsrc),"s"(lds_dst):"memory");}
__device__ __forceinline__ float max3f(float a,float b,float c){float r;asm("v_max3_f32 %0, %1, %2, %3":"=v"(r):"v"(a),"v"(b),"v"(c));return r;}
__device__ __forceinline__ float max2f(float a,float b){float r;asm("v_max_f32_e32 %0, %1, %2":"=v"(r):"v"(a),"v"(b));return r;}
__device__ __forceinline__ float fadd_s(float a,float b){float r;asm("v_add_f32_e32 %0, %1, %2":"=v"(r):"v"(a),"v"(b));return r;}
__device__ __forceinline__ float fsub_s(float a,float b){float r;asm("v_sub_f32_e32 %0, %1, %2":"=v"(r):"v"(a),"v"(b));return r;}
typedef float f32x2_t __attribute__((ext_vector_type(2))); typedef __bf16 bf16x2_t __attribute__((ext_vector_type(2)));
__device__ __forceinline__ unsigned cvtpk_s(float lo,float hi){f32x2_t v={lo,hi};bf16x2_t b=__builtin_convertvector(v,bf16x2_t);return __builtin_bit_cast(unsigned,b);}
#define WAIT_BAR(N) asm volatile("s_waitcnt vmcnt(" #N ") lgkmcnt(0)\n\ts_barrier":::"memory")

__device__ __forceinline__ void qkt(f32x16&p0,f32x16&p1,const char*Kslot,const bf16x8*qr,int r32,int hi){
  const f32x16 zc=f32x16{};
  const char*kb=Kslot+hi*1024+r32*16;
  #pragma unroll
  for(int d0=0;d0<4;++d0){
    const bf16x8 b0=*reinterpret_cast<const bf16x8*>(kb+d0*2048);
    const bf16x8 b1=*reinterpret_cast<const bf16x8*>(kb+d0*2048+512);
    if(d0==0){p0=__builtin_amdgcn_mfma_f32_32x32x16_bf16(b0,qr[0],zc,0,0,0);p1=__builtin_amdgcn_mfma_f32_32x32x16_bf16(b1,qr[0],zc,0,0,0);}
    else{p0=__builtin_amdgcn_mfma_f32_32x32x16_bf16(b0,qr[d0],p0,0,0,0);p1=__builtin_amdgcn_mfma_f32_32x32x16_bf16(b1,qr[d0],p1,0,0,0);}}
}
typedef __attribute__((address_space(3))) const char* lds_cptr;
typedef short v4i16_t __attribute__((ext_vector_type(4)));
__device__ __forceinline__ void kload8(bf16x8*kf,lds_cptr kp){
  kf[0]=*(const __attribute__((address_space(3))) bf16x8*)(kp);      kf[1]=*(const __attribute__((address_space(3))) bf16x8*)(kp+512);
  kf[2]=*(const __attribute__((address_space(3))) bf16x8*)(kp+2048); kf[3]=*(const __attribute__((address_space(3))) bf16x8*)(kp+2560);
  kf[4]=*(const __attribute__((address_space(3))) bf16x8*)(kp+4096); kf[5]=*(const __attribute__((address_space(3))) bf16x8*)(kp+4608);
  kf[6]=*(const __attribute__((address_space(3))) bf16x8*)(kp+6144); kf[7]=*(const __attribute__((address_space(3))) bf16x8*)(kp+6656);
}
__device__ __forceinline__ void kload2(bf16x8*kf,lds_cptr kp,int j){ kf[2*j]=*(const __attribute__((address_space(3))) bf16x8*)(kp+j*2048); kf[2*j+1]=*(const __attribute__((address_space(3))) bf16x8*)(kp+j*2048+512); }
__device__ __forceinline__ s16x4 vtr(lds_cptr p){ return __builtin_bit_cast(s16x4,__builtin_amdgcn_ds_read_tr16_b64_v4i16((__attribute__((address_space(3))) v4i16_t*)p)); }
__device__ __forceinline__ float rowmax(const f32x16&p0,const f32x16&p1){
  float a=max3f(p0[0],p0[1],p1[0]),b=max3f(p0[2],p0[3],p1[1]);a=max3f(a,p1[2],p1[3]);
  #pragma unroll
  for(int r=4;r<16;r+=4){a=max3f(a,p0[r],p0[r+1]);b=max3f(b,p0[r+2],p0[r+3]);a=max3f(a,p1[r],p1[r+1]);b=max3f(b,p1[r+2],p1[r+3]);}
  const float m=max2f(a,b);
  auto rr=__builtin_amdgcn_permlane32_swap(__float_as_uint(m),__float_as_uint(m),false,false);
  return max2f(__uint_as_float(rr[0]),__uint_as_float(rr[1]));
}
__device__ __forceinline__ void pv(f32x16*o,int vb,bf16x8 pa0,bf16x8 pa1,bf16x8 pa2,bf16x8 pa3){
  #pragma unroll
  for(int d0=0;d0<4;++d0){s16x4 lo[4],hi[4];
    #pragma unroll
    for(int ks=0;ks<4;++ks){
      asm volatile("ds_read_b64_tr_b16 %0,%1 offset:%c2":"=&v"(lo[ks]):"v"(vb),"i"(d0*4096+ks*1024):"memory");
      asm volatile("ds_read_b64_tr_b16 %0,%1 offset:%c2":"=&v"(hi[ks]):"v"(vb),"i"(d0*4096+ks*1024+512):"memory");}
    asm volatile("s_waitcnt lgkmcnt(0)":::"memory");SBAR();
    #define PK(k) (bf16x8){lo[k][0],lo[k][1],lo[k][2],lo[k][3],hi[k][0],hi[k][1],hi[k][2],hi[k][3]}
    o[d0]=__builtin_amdgcn_mfma_f32_32x32x16_bf16(pa0,PK(0),o[d0],0,0,0);
    o[d0]=__builtin_amdgcn_mfma_f32_32x32x16_bf16(pa1,PK(1),o[d0],0,0,0);
    o[d0]=__builtin_amdgcn_mfma_f32_32x32x16_bf16(pa2,PK(2),o[d0],0,0,0);
    o[d0]=__builtin_amdgcn_mfma_f32_32x32x16_bf16(pa3,PK(3),o[d0],0,0,0);
    #undef PK
  }
}

#ifndef ATTN_STORE16
#define ATTN_STORE16(p,v) (*(u32x4*)(p)=(v))
#endif
template<int THRL> __device__ __forceinline__ void attn_unit(int b,int qoff,int koff,int voff,int ooff,int qb,const bf16*Q,const bf16*__restrict__ K,const bf16*__restrict__ V,bf16*O,char*shm,bool comb,bf16*OUT,float lam,const float*gsv){
  int tid_l=threadIdx.x; asm volatile("":"+v"(tid_l)); const int tid=tid_l,lane=tid&63,r32=lane&31,hi=lane>>5; const int wid=__builtin_amdgcn_readfirstlane(tid>>6);
  const long rowbase=(long)b*SEQ; const int q0=qb*QB;
  const bf16*Qw=Q+(rowbase+q0+wid*QBLK)*QKVP+qoff;
  const bf16*Kh=K+rowbase*QKVP+koff,*Vh=V+rowbase*QKVP+voff;
  const unsigned lds0=(unsigned)(uintptr_t)shm;
  float*wsf=(float*)(shm+LDS_WS)+wid*64;
  const bf16*ksrc=Kh+(long)lane*QKVP+wid*8;
  const bf16*vsrc=Vh+(long)(16*(wid&3)+(lane>>2))*QKVP+(wid>>2)*32+(lane&3)*8;
  const unsigned kdst=lds0+LDS_K+wid*1024, vdst=lds0+LDS_V+wid*1024;
  #define DMA_K(t,slot) glds16(ksrc+(long)(t)*KVBLK*QKVP,(unsigned)__builtin_amdgcn_readfirstlane(kdst+(slot)))
  #define DMA_V(t,slot) do{ glds16(vsrc+(long)(t)*KVBLK*QKVP,(unsigned)__builtin_amdgcn_readfirstlane(vdst+2*(slot))); glds16(vsrc+(long)(t)*KVBLK*QKVP+64,(unsigned)__builtin_amdgcn_readfirstlane(vdst+2*(slot)+8192)); }while(0)
  const int vb0=(int)(lds0+LDS_V)+((lane>>4)&1)*32+(lane&3)*8+(4*hi+((lane&15)>>2))*64;
  const char*Kbase=shm+LDS_K; bf16x8 kf[8];
  const lds_cptr shm3=(lds_cptr)shm; const lds_cptr kp0=shm3+LDS_K+hi*1024+r32*16; const lds_cptr vp0=shm3+LDS_V+((lane>>4)&1)*32+(lane&3)*8+(4*hi+((lane&15)>>2))*64;
  const int NT=(q0+QB)/KVBLK;
  DMA_K(0,0);DMA_V(0,0);DMA_K(1,SLOTB);
  bf16x8 qr[4];
  #pragma unroll
  for(int d0=0;d0<4;++d0)qr[d0]=*reinterpret_cast<const bf16x8*>(&Qw[(long)r32*QKVP+d0*16+hi*8]);
  float mhat=0.f,l_reg=0.f;f32x16 o[4];o[0]=f32x16{};o[1]=f32x16{};o[2]=f32x16{};o[3]=f32x16{};
  const int qrel=wid*QBLK+r32;
  #define CMASK(P0,P1,t) do{int jb_=(t)-(NT-4); if(jb_>=0)cmask(P0,P1,jb_,qrel,hi);}while(0)
  bool resc=false;
  #define START(P0,P1) do{ const float rm=rowmax(P0,P1); resc=false; \
    { const float dl=rm; mhat=fadd_s(mhat,dl); \
      _Pragma("unroll") for(int r=0;r<16;++r){P0[r]=fsub_s(P0[r],dl);P1[r]=fsub_s(P1[r],dl);} } \
    _Pragma("unroll") for(int r=0;r<16;++r)P0[r]=__builtin_amdgcn_exp2f(P0[r]); }while(0)
  #define RESC() do{ if(resc){ asm volatile("s_waitcnt lgkmcnt(0)":::"memory"); \
      _Pragma("unroll") for(int d_=0;d_<4;++d_) _Pragma("unroll") for(int r=0;r<16;++r)o[d_][r]*=wsf[crow(r,hi)]; } }while(0)
  f32x16 pA0,pA1,pB0,pB1; const f32x16 zero16=f32x16{};
  int sl_prev=0,sl_cur=0,sl_next=SLOTB;
  #define ROT() do{sl_prev=sl_cur;sl_cur=sl_next;sl_next=(sl_next==(NSLOT-1)*SLOTB)?0:sl_next+SLOTB;}while(0)
  DMA_K(2,2*SLOTB);
  WAIT_BAR(4);
  qkt(pA0,pA1,Kbase,qr,r32,hi);asm volatile("s_nop 15\n\ts_nop 7":"+v"(pA0),"+v"(pA1));CMASK(pA0,pA1,0);
  START(pA0,pA1);
  _Pragma("unroll") for(int r=0;r<16;++r)pA1[r]=__builtin_amdgcn_exp2f(pA1[r]);
  WAIT_BAR(0);
  DMA_K(3,0);DMA_V(1,SLOTB);
  ROT();
  kload8(kf,kp0+sl_cur);
  WAIT_BAR(3);
  s16x4 vlo[8],vhi[8]; u32x4 pw0,pw1,pw2,pw3;
  #define PKW(P,B) cvtpk_s(P[B],P[B+1])
  #define PAF(k) __builtin_bit_cast(bf16x8,pw##k)
  #define VFR(i) (bf16x8){vlo[i][0],vlo[i][1],vlo[i][2],vlo[i][3],vhi[i][0],vhi[i][1],vhi[i][2],vhi[i][3]}
  #define PIN(x) asm volatile("":"+v"(x))
  #define MX3(a,b,c) __builtin_fmaxf(__builtin_fmaxf((a),(b)),(c))
  #define GAPA(MF,A0,A1,A2,A3,W0,W1,PW) do{ MF; sacc+=A0; sacc+=A1; sacc+=A2; sacc+=A3; PIN(sacc); W0; W1; PIN(PW); SBAR(); }while(0)
  #define EX(v) __builtin_amdgcn_exp2f(v)
  #define GAPB(MF,X,B,EXTRA) do{ MF; X[B]=EX(X[B]); X[B+1]=EX(X[B+1]); EXTRA; PIN(X); SBAR(); }while(0)
  #define VLD(i,f) do{ vlo[i]=vtr(vp_+(((f)>>2)*4096+((f)&3)*1024)); vhi[i]=vtr(vp_+(((f)>>2)*4096+((f)&3)*1024+512)); }while(0)
  #define VRD(i) do{ vlo[i]=vtr(vp_+(((i)>>2)*4096+((i)&3)*1024)); vhi[i]=vtr(vp_+(((i)>>2)*4096+((i)&3)*1024+512)); }while(0)
  #define KRD(G,j) do{ if(G){ kload2(kf,kp0+sl_next,j); SBAR(); } }while(0)
  #define STEP(C0,C1,P0,P1,t,GK,GV,GL) do{ SBAR(); \
    const lds_cptr vp_=vp0+2*sl_prev; \
    VRD(0); SBAR(); float sacc=(P0[0]+P0[1]); \
    GAPA(C0=__builtin_amdgcn_mfma_f32_32x32x16_bf16(kf[0],qr[0],zero16,0,0,0), P0[2],P0[3],P0[4],P0[5],     pw0[0]=PKW(P0,0), pw0[1]=PKW(P0,2), pw0); \
    VRD(4); SBAR(); GAPA(C1=__builtin_amdgcn_mfma_f32_32x32x16_bf16(kf[1],qr[0],zero16,0,0,0), P0[6],P0[7],P0[8],P0[9],     pw0[2]=PKW(P0,4), pw0[3]=PKW(P0,6), pw0); \
    VRD(1); SBAR(); GAPA(C0=__builtin_amdgcn_mfma_f32_32x32x16_bf16(kf[2],qr[1],C0,0,0,0),   P0[10],P0[11],P0[12],P0[13], pw1[0]=PKW(P0,8), pw1[1]=PKW(P0,10), pw1); \
    VRD(5); SBAR(); GAPA(C1=__builtin_amdgcn_mfma_f32_32x32x16_bf16(kf[3],qr[1],C1,0,0,0),   P0[14],P0[15],P1[0],P1[1],   pw1[2]=PKW(P0,12),pw1[3]=PKW(P0,14), pw1); \
    GAPA(C0=__builtin_amdgcn_mfma_f32_32x32x16_bf16(kf[4],qr[2],C0,0,0,0),   P1[2],P1[3],P1[4],P1[5],     pw2[0]=PKW(P1,0), pw2[1]=PKW(P1,2), pw2); \
    GAPA(C1=__builtin_amdgcn_mfma_f32_32x32x16_bf16(kf[5],qr[2],C1,0,0,0),   P1[6],P1[7],P1[8],P1[9],     pw2[2]=PKW(P1,4), pw2[3]=PKW(P1,6), pw2); \
    GAPA(C0=__builtin_amdgcn_mfma_f32_32x32x16_bf16(kf[6],qr[3],C0,0,0,0),   P1[10],P1[11],P1[12],P1[13], pw3[0]=PKW(P1,8), pw3[1]=PKW(P1,10), pw3); \
    GAPA(C1=__builtin_amdgcn_mfma_f32_32x32x16_bf16(kf[7],qr[3],C1,0,0,0),   P1[14],P1[15],0.f,0.f,       pw3[2]=PKW(P1,12),pw3[3]=PKW(P1,14), pw3); \
    l_reg+=sacc; \
    if(GK){DMA_K((t)+3,sl_cur);} if(GV){DMA_V((t)+1,sl_next);} \
    CMASK(C0,C1,t); \
    { float a=MX3(C0[0],C0[1],C1[0]),b=MX3(C0[2],C0[3],C1[1]); a=MX3(a,C1[2],C1[3]); \
      _Pragma("unroll") for(int r=4;r<16;r+=4){a=MX3(a,C0[r],C0[r+1]);b=MX3(b,C0[r+2],C0[r+3]);a=MX3(a,C1[r],C1[r+1]);b=MX3(b,C1[r+2],C1[r+3]);} \
      float rm=__builtin_fmaxf(a,b); { auto rr=__builtin_amdgcn_permlane32_swap(__float_as_uint(rm),__float_as_uint(rm),false,false); rm=__builtin_fmaxf(__uint_as_float(rr[0]),__uint_as_float(rr[1])); } \
      rm-=mhat; resc=false;     \
      if(__builtin_expect(__any(rm>(float)THRL),0)){ const float dl=__builtin_fmaxf(rm,0.f); mhat+=dl; \
        const float f=__builtin_amdgcn_exp2f(-dl); l_reg*=f; if(hi==0)wsf[r32]=f; resc=true; } \
      C0=C0-mhat; C1=C1-mhat; } \
    SBAR(); \
    GAPB(o[0]=__builtin_amdgcn_mfma_f32_32x32x16_bf16(PAF(0),VFR(0),o[0],0,0,0), C0,0, VLD(2,2)); \
    GAPB(o[1]=__builtin_amdgcn_mfma_f32_32x32x16_bf16(PAF(0),VFR(4),o[1],0,0,0), C0,2, VLD(6,6)); \
    KRD(GL,0); GAPB(o[0]=__builtin_amdgcn_mfma_f32_32x32x16_bf16(PAF(1),VFR(1),o[0],0,0,0), C0,4, VLD(3,3)); \
    KRD(GL,1); GAPB(o[1]=__builtin_amdgcn_mfma_f32_32x32x16_bf16(PAF(1),VFR(5),o[1],0,0,0), C0,6, VLD(7,7)); \
    KRD(GL,2); GAPB(o[0]=__builtin_amdgcn_mfma_f32_32x32x16_bf16(PAF(2),VFR(2),o[0],0,0,0), C0,8, VLD(0,8)); \
    KRD(GL,3); GAPB(o[1]=__builtin_amdgcn_mfma_f32_32x32x16_bf16(PAF(2),VFR(6),o[1],0,0,0), C0,10, VLD(4,12)); \
    GAPB(o[0]=__builtin_amdgcn_mfma_f32_32x32x16_bf16(PAF(3),VFR(3),o[0],0,0,0), C0,12, VLD(1,9)); \
    GAPB(o[1]=__builtin_amdgcn_mfma_f32_32x32x16_bf16(PAF(3),VFR(7),o[1],0,0,0), C0,14, VLD(5,13)); \
    GAPB(o[2]=__builtin_amdgcn_mfma_f32_32x32x16_bf16(PAF(0),VFR(0),o[2],0,0,0), C1,0, VLD(2,10)); \
    GAPB(o[3]=__builtin_amdgcn_mfma_f32_32x32x16_bf16(PAF(0),VFR(4),o[3],0,0,0), C1,2, VLD(6,14)); \
    GAPB(o[2]=__builtin_amdgcn_mfma_f32_32x32x16_bf16(PAF(1),VFR(1),o[2],0,0,0), C1,4, VLD(3,11)); \
    GAPB(o[3]=__builtin_amdgcn_mfma_f32_32x32x16_bf16(PAF(1),VFR(5),o[3],0,0,0), C1,6, VLD(7,15)); \
    GAPB(o[2]=__builtin_amdgcn_mfma_f32_32x32x16_bf16(PAF(2),VFR(2),o[2],0,0,0), C1,8, (void)0); \
    GAPB(o[3]=__builtin_amdgcn_mfma_f32_32x32x16_bf16(PAF(2),VFR(6),o[3],0,0,0), C1,10, (void)0); \
    GAPB(o[2]=__builtin_amdgcn_mfma_f32_32x32x16_bf16(PAF(3),VFR(3),o[2],0,0,0), C1,12, (void)0); \
    GAPB(o[3]=__builtin_amdgcn_mfma_f32_32x32x16_bf16(PAF(3),VFR(7),o[3],0,0,0), C1,14, (void)0); \
    }while(0)
  int t=1;
  #undef CMASK
  #define CMASK(P0,P1,t) do{}while(0)
  for(;t+5<NT;t+=2){
    STEP(pB0,pB1,pA0,pA1,t,true,true,true);     WAIT_BAR(3); RESC(); ROT();
    STEP(pA0,pA1,pB0,pB1,t+1,true,true,true);   WAIT_BAR(3); RESC(); ROT();
  }
  #undef CMASK
  #define CMASK(P0,P1,t) do{int jb_=(t)-(NT-4); if(jb_>=0)cmask(P0,P1,jb_,qrel,hi);}while(0)
  #define ENDW(tt) do{ if((tt)+3<NT){WAIT_BAR(3);} else if((tt)+2<NT){WAIT_BAR(2);} else {WAIT_BAR(0);} }while(0)
  for(;t+1<NT;t+=2){
    STEP(pB0,pB1,pA0,pA1,t,(t+3<NT),(t+1<NT),(t+1<NT));       ENDW(t);   RESC(); ROT();
    STEP(pA0,pA1,pB0,pB1,t+1,(t+4<NT),(t+2<NT),(t+2<NT));     ENDW(t+1); RESC(); ROT();
  }
  STEP(pB0,pB1,pA0,pA1,NT-1,false,false,false); RESC();
  { float sacc=pB0[0]+pB0[1]; _Pragma("unroll") for(int r=2;r<16;++r)sacc+=pB0[r]; _Pragma("unroll") for(int r=0;r<16;++r)sacc+=pB1[r]; l_reg+=sacc;
    pw0=(u32x4){PKW(pB0,0),PKW(pB0,2),PKW(pB0,4),PKW(pB0,6)};pw1=(u32x4){PKW(pB0,8),PKW(pB0,10),PKW(pB0,12),PKW(pB0,14)};pw2=(u32x4){PKW(pB1,0),PKW(pB1,2),PKW(pB1,4),PKW(pB1,6)};pw3=(u32x4){PKW(pB1,8),PKW(pB1,10),PKW(pB1,12),PKW(pB1,14)};
    SBAR(); pv(o,vb0+2*sl_cur,PAF(0),PAF(1),PAF(2),PAF(3)); }
  #undef PKW
  #undef PAF
  #undef VFR
  #undef PIN
  #undef MX3
  #undef GAPA
  #undef GAPB
  #undef EX
  #undef VRD
  #undef VLD
  #undef KRD
  #undef STEP
  #undef ENDW
  {auto rr=__builtin_amdgcn_permlane32_swap(__float_as_uint(l_reg),__float_as_uint(l_reg),false,false);l_reg=__uint_as_float(rr[0])+__uint_as_float(rr[1]);}
  if(hi==0)wsf[32+r32]=l_reg;asm volatile("s_waitcnt lgkmcnt(0)":::"memory");
  float rli[16];
  #pragma unroll
  for(int r=0;r<16;++r)rli[r]=__builtin_amdgcn_rcpf(wsf[32+crow(r,hi)]);
  bf16*Ow=O+(rowbase+q0+wid*QBLK)*OP+ooff;
  asm volatile("s_waitcnt lgkmcnt(0)\n\ts_barrier":::"memory");
  { bf16*stg=(bf16*)(shm+LDS_OST)+wid*4096;
    #pragma unroll
    for(int r=0;r<16;++r){const int orow=crow(r,hi);
      #pragma unroll
      for(int d0=0;d0<4;++d0)stg[orow*128+d0*32+r32]=__float2bfloat16(o[d0][r]*rli[r]);}
    asm volatile("s_waitcnt lgkmcnt(0)":::"memory");
    if(!comb){
      #pragma unroll
      for(int i=0;i<8;++i){const int row=i*4+(lane>>4),ch=lane&15; const u32x4 v=*(const u32x4*)(stg+row*128+ch*8); ATTN_STORE16(Ow+(long)row*OP+ch*8,v);}
    } else {
      const int ch=lane&15; float gs[8];
      #pragma unroll
      for(int k=0;k<8;++k)gs[k]=gsv[ch*8+k];
      bf16*Uw=OUT+(rowbase+q0+wid*QBLK)*OP+ooff;
      asm volatile("s_waitcnt vmcnt(0)":::"memory");
      #pragma unroll
      for(int i=0;i<8;++i){const int row=i*4+(lane>>4);
        const u32x4 v1=*(const u32x4*)(stg+row*128+ch*8); const u32x4 v0=*(const u32x4*)(Ow+(long)row*OP+ch*8);
        float d[8]; float ss=0.f;
        #pragma unroll
        for(int k=0;k<4;++k){ const unsigned a=v0[k], c1=v1[k];
          d[2*k]=__uint_as_float(a<<16)-lam*__uint_as_float(c1<<16); d[2*k+1]=__uint_as_float(a&0xffff0000u)-lam*__uint_as_float(c1&0xffff0000u);
          ss+=d[2*k]*d[2*k]+d[2*k+1]*d[2*k+1]; }
        ss+=__shfl_xor(ss,1); ss+=__shfl_xor(ss,2); ss+=__shfl_xor(ss,4); ss+=__shfl_xor(ss,8);
        const float rs=1.0f/sqrtf(ss*(1.0f/128.0f)+1e-6f);
        u32x4 w;
        #pragma unroll
        for(int k=0;k<4;++k) w[k]=cvtpk_s(d[2*k]*rs*gs[2*k],d[2*k+1]*rs*gs[2*k+1]);
        ATTN_STORE16(Uw+(long)row*OP+ch*8,w); }
    } }
  asm volatile("s_waitcnt lgkmcnt(0)\n\ts_barrier":::"memory");
  #undef DMA_K
  #undef DMA_V
  #undef CMASK
  #undef START
  #undef RESC
  #undef ROT
}
constexpr int ATTN_LDS_BYTES=LDS_BYTES;
struct AttnTensors { const bf16* Q; const bf16* K; const bf16* V; bf16* O0; bf16* OUT; const float* lam; const float* subln; int layer_idx; };
template<int THRL=8> __device__ __forceinline__ void attn_phase(char*lds,const AttnTensors&T,int vcu,int G){
  float lam_val, lam_init;
  int tx=threadIdx.x; asm volatile("":"+v"(tx));
  { const int lane=tx&63; float s01=T.lam[lane]*T.lam[64+lane], s23=T.lam[128+lane]*T.lam[192+lane];
    #pragma unroll
    for(int o=1;o<64;o<<=1){ s01+=__shfl_xor(s01,o); s23+=__shfl_xor(s23,o); }
    lam_init=0.8f-0.6f*__expf(-0.3f*(float)T.layer_idx); lam_val=__expf(s01)-__expf(s23)+lam_init; }
  float* gsv=(float*)(lds+LDS_WS+NW*256);
  if(tx<128) gsv[tx]=T.subln[tx]*(1.0f-lam_init);
  __syncthreads();
  const int ni=(G==256)?4:(BATCH*8*NQB-vcu+G-1)/G;
  for(int i2=0;i2<2*ni;++i2){
    const int i=i2>>1, c=i2&1; int b,h,qb;
    if(G==256){ b=vcu>>5; h=(vcu&31)>>2; const int q=vcu&3; qb=(i==0)?15-q:(i==1)?8+q:(i==2)?7-q:q; }
    else{ const int uid=vcu+i*G; qb=uid&15; h=(uid>>4)&7; b=uid>>7; }
    attn_unit<THRL>(b,(c*8+h)*64,(c*8+h)*64,h*128,h*128,qb,T.Q,T.K,T.V,T.O0,lds,c!=0,T.OUT,lam_val,gsv);
  }
}
#undef SBAR
#undef WAIT_BAR
}

#define GAS __attribute__((address_space(1)))
#define LAS __attribute__((address_space(3)))
typedef unsigned short bf16;
typedef unsigned v4u __attribute__((ext_vector_type(4)));
typedef float f32x4 __attribute__((ext_vector_type(4)));
typedef short bf16x8 __attribute__((ext_vector_type(8)));
typedef GAS unsigned gu32;
typedef GAS unsigned long long gu64;
#define RLX_AGENT __ATOMIC_RELAXED, __HIP_MEMORY_SCOPE_AGENT
#define LDS_WAIT() asm volatile("s_waitcnt lgkmcnt(0)" ::: "memory")
#define VM_WAIT() asm volatile("s_waitcnt vmcnt(0)" ::: "memory")
__device__ __forceinline__ unsigned long long rt() { return __builtin_amdgcn_s_memrealtime(); }
__device__ __forceinline__ unsigned f2bf(float f) { unsigned u = __builtin_bit_cast(unsigned, f); return (u + 0x7fffu + ((u >> 16) & 1u)) >> 16; }
__device__ __forceinline__ unsigned pk2(float lo, float hi) { return f2bf(lo) | (f2bf(hi) << 16); }

#define XB_TMO      128
#define XB_XCNT(j)  (256  + 64 * (j))
#define XB_XSUB(j)  (1280 + 64 * (j))
#define XB_XGEN(j)  (2304 + 64 * (j))
#define XB_TOP      3328
#define XB_TOPGEN   3392
#define XCD_BAR_WORDS 3456
#define XB_SPIN_CAP (1u << 18)

__device__ __forceinline__ unsigned xb_ld(unsigned* p)              { return __hip_atomic_load(p, __ATOMIC_RELAXED, __HIP_MEMORY_SCOPE_AGENT); }
__device__ __forceinline__ unsigned xb_add(unsigned* p, unsigned v) { return __hip_atomic_fetch_add(p, v, __ATOMIC_RELAXED, __HIP_MEMORY_SCOPE_AGENT); }
__device__ __forceinline__ unsigned xb_xcc_id() { return (unsigned)__builtin_amdgcn_s_getreg((3 << 11) | 20) & 0xFu; }
#define XB_SPIN(cond, bar) do { unsigned _sp = 0; while (cond) { __builtin_amdgcn_s_sleep(1); \
    if ((++_sp & 255u) == 0u) { if (xb_ld(&(bar)[XB_TMO])) break; if (_sp > XB_SPIN_CAP) { atomicAdd(&(bar)[XB_TMO], 1u); break; } } } } while (0)

struct XcdBarrier {
    unsigned* bar; unsigned x;
    volatile LAS unsigned* st;
};

__device__ __forceinline__ XcdBarrier xcd_barrier_post(unsigned* bar, volatile LAS unsigned* st) {
    XcdBarrier b; b.bar = bar; b.x = xb_xcc_id(); b.st = st;
    if (threadIdx.x == 0) st[2] = xb_add(&bar[XB_XCNT(b.x)], 1u);
    return b;
}
__device__ __forceinline__ void xcd_barrier_complete(unsigned* bar, unsigned x, unsigned& nloc, unsigned& nx, bool& uni) {
    const unsigned G = gridDim.x * gridDim.y * gridDim.z;
    unsigned sum, cnt, mine, odd, sp = 0u;
    for (;;) {
        sum = 0u; cnt = 0u; mine = 0u; odd = 0u;
#pragma unroll
        for (unsigned j = 0; j < 16; ++j) { const unsigned c = xb_ld(&bar[XB_XCNT(j)]); sum += c; cnt += (c > 0u) ? 1u : 0u; mine = (j == x) ? c : mine; odd += (c != 0u && (c != 32u || j >= 8u)) ? 1u : 0u; }
        if (sum == G) break;
        __builtin_amdgcn_s_sleep(1);
        if ((++sp & 255u) == 0u) { if (xb_ld(&bar[XB_TMO])) break; if (sp > XB_SPIN_CAP) { atomicAdd(&bar[XB_TMO], 1u); break; } }
    }
    nloc = mine > 0u ? mine : 1u; nx = cnt > 0u ? cnt : 1u;
    uni = (sum == G) && (G == 256u) && (cnt == 8u) && (odd == 0u);
}

__device__ __forceinline__ void xcd_barrier(const XcdBarrier& b) {
    asm volatile("s_waitcnt vmcnt(0)" ::: "memory");
    __syncthreads();
    if (threadIdx.x == 0) {
        unsigned* bar = b.bar;
        __builtin_amdgcn_s_waitcnt(0);
        unsigned nloc = b.st[0], nx = b.st[1];
        if (nloc == 0u) { bool uni; xcd_barrier_complete(bar, b.x, nloc, nx, uni); b.st[0] = nloc; b.st[1] = nx; b.st[3] = uni ? 1u + b.st[2] * 8u + b.x : 0u; }
        const unsigned old = xb_add(&bar[XB_XSUB(b.x)], 1u);
        const unsigned gen = old / nloc;
        if (old + 1u == (gen + 1u) * nloc) {
            __builtin_amdgcn_fence(__ATOMIC_RELEASE, "agent");
            asm volatile("s_waitcnt vmcnt(0)" ::: "memory");
            const unsigned og = xb_add(&bar[XB_TOP], 1u);
            const unsigned tg = og / nx;
            if (og + 1u == (tg + 1u) * nx) xb_add(&bar[XB_TOPGEN], 1u);
            else XB_SPIN(xb_ld(&bar[XB_TOPGEN]) == tg, bar);
            __builtin_amdgcn_fence(__ATOMIC_ACQUIRE, "agent");
            xb_add(&bar[XB_XGEN(b.x)], 1u);
            asm volatile("s_waitcnt vmcnt(0)" ::: "memory");
        } else {
            XB_SPIN(xb_ld(&bar[XB_XGEN(b.x)]) == gen, bar);
            __builtin_amdgcn_fence(__ATOMIC_ACQUIRE, "agent");
            asm volatile("s_waitcnt vmcnt(0)" ::: "memory");
        }
    }
    __syncthreads();
}

__device__ __forceinline__ unsigned lds_word_uniform(unsigned byte_addr) { unsigned a = byte_addr; asm volatile("" : "+s"(a)); unsigned v;
    asm volatile("v_mov_b32 %0, %1\n\tds_read_b32 %0, %0\n\ts_waitcnt lgkmcnt(0)" : "=&v"(v) : "s"(a) : "memory"); return (unsigned)__builtin_amdgcn_readfirstlane(v); }
__device__ __forceinline__ void xcd_local_barrier(const XcdBarrier& b) {
    asm volatile("s_waitcnt vmcnt(0)" ::: "memory");
    __syncthreads();
    if (threadIdx.x == 0) {
        unsigned* bar = b.bar;
        __builtin_amdgcn_s_waitcnt(0);
        const unsigned nloc = b.st[0];
        const unsigned old = xb_add(&bar[XB_XSUB(b.x)], 1u);
        const unsigned gen = old / nloc;
        if (old + 1u == (gen + 1u) * nloc) xb_add(&bar[XB_XGEN(b.x)], 1u);
        else XB_SPIN(xb_ld(&bar[XB_XGEN(b.x)]) == gen, bar);
        __builtin_amdgcn_fence(__ATOMIC_ACQUIRE, "agent");
        asm volatile("s_waitcnt vmcnt(0)" ::: "memory");
    }
    __syncthreads();
}

namespace dsa {
constexpr size_t SLAB_EL = 4194304;
constexpr int PA = 3072, QOFF = 0, KOFF = 1024, VOFF = 1088, QIOFF = 1152, KIOFF = 1664;
constexpr int SEQ = 4096, SC_STRIDE = 4096, LDS_SC = 0, LDS_IDX = 131072, LDS_DUMMY = 135680, TOPK = 256;
typedef short bf16x8 __attribute__((ext_vector_type(8)));
typedef short s16x4 __attribute__((ext_vector_type(4)));
typedef float f32x16 __attribute__((ext_vector_type(16)));
typedef float f32x4 __attribute__((ext_vector_type(4)));
typedef unsigned u32x4 __attribute__((ext_vector_type(4)));
typedef unsigned u32x2 __attribute__((ext_vector_type(2)));
typedef float f32x2 __attribute__((ext_vector_type(2)));
typedef unsigned short bf16_t;
#define DSA_LAS __attribute__((address_space(3)))
__device__ __forceinline__ unsigned cvtpk(float lo, float hi) { unsigned r; asm volatile("v_cvt_pk_bf16_f32 %0, %1, %2" : "=v"(r) : "v"(lo), "v"(hi)); return r; }
__device__ __forceinline__ float relu1(float x) { return __builtin_amdgcn_fmed3f(x, 0.0f, __builtin_inff()); }
__device__ __forceinline__ int mbcnt64(unsigned long long m) { return (int)__builtin_amdgcn_mbcnt_hi((unsigned)(m >> 32), __builtin_amdgcn_mbcnt_lo((unsigned)m, 0u)); }
__device__ __forceinline__ s16x4 trrd(DSA_LAS const unsigned char* p) { typedef short v4i16_t __attribute__((ext_vector_type(4))); return __builtin_bit_cast(s16x4, __builtin_amdgcn_ds_read_tr16_b64_v4i16((DSA_LAS v4i16_t*)p)); }
__device__ __forceinline__ int dpp_scan_add(int x) {
    x += __builtin_amdgcn_update_dpp(0, x, 0x111, 0xf, 0xf, false);
    x += __builtin_amdgcn_update_dpp(0, x, 0x112, 0xf, 0xf, false);
    x += __builtin_amdgcn_update_dpp(0, x, 0x114, 0xf, 0xf, false);
    x += __builtin_amdgcn_update_dpp(0, x, 0x118, 0xf, 0xf, false);
    x += __builtin_amdgcn_update_dpp(0, x, 0x142, 0xa, 0xf, false);
    x += __builtin_amdgcn_update_dpp(0, x, 0x143, 0xc, 0xf, false);
    return x;
}
__device__ __forceinline__ int wave_total(int x) { return __builtin_amdgcn_readlane(dpp_scan_add(x), 63); }
__device__ __forceinline__ float dpp_max_all(float x) {
    const int NI = (int)0xff800000u;
#define DSA_MX(ctrl, rm) x = __builtin_fmaxf(x, __builtin_bit_cast(float, __builtin_amdgcn_update_dpp(NI, __builtin_bit_cast(int, x), ctrl, rm, 0xf, false)))
    DSA_MX(0x111, 0xf); DSA_MX(0x112, 0xf); DSA_MX(0x114, 0xf); DSA_MX(0x118, 0xf); DSA_MX(0x142, 0xa); DSA_MX(0x143, 0xc);
#undef DSA_MX
    return __builtin_bit_cast(float, __builtin_amdgcn_readlane(__builtin_bit_cast(int, x), 63));
}
__device__ __forceinline__ void glds16(const void* gsrc, unsigned lds_dst) { unsigned keep;
    asm volatile("s_mov_b32 %0, m0\n\ts_mov_b32 m0, %2\n\ts_nop 0\n\tglobal_load_lds_dwordx4 %1, off\n\ts_mov_b32 m0, %0" : "=&s"(keep) : "v"(gsrc), "s"(lds_dst) : "memory"); }

constexpr int IDX_D = 4;
struct IdxQ { bf16x8 A[2][4]; float w[2][16]; };
__device__ __forceinline__ void index_load_q(IdxQ& q, const bf16_t* __restrict__ P, const float* __restrict__ WI, long rowbase, int t0, int lane) {
    const int r = lane & 31, h8 = lane >> 5;
    const int tok = 2 * ((r >> 2) & 1) + (r >> 4), head = 4 * ((r >> 3) & 1) + (r & 3);
#pragma unroll
    for (int rt = 0; rt < 2; ++rt) {
        const bf16_t* qp = P + (size_t)(rowbase + t0 + 4 * rt + tok) * PA + QIOFF + head * 64 + 8 * h8;
#pragma unroll
        for (int s = 0; s < 4; ++s) q.A[rt][s] = *(const bf16x8*)(qp + 16 * s);
#pragma unroll
        for (int qq = 0; qq < 2; ++qq) { const float* wp = WI + (size_t)(rowbase + t0 + 4 * rt + 2 * h8 + qq) * 8; const f32x4 wa = *(const f32x4*)wp, wb = *(const f32x4*)(wp + 4);
#pragma unroll
            for (int i = 0; i < 4; ++i) { q.w[rt][8 * qq + i] = wa[i]; q.w[rt][8 * qq + 4 + i] = wb[i]; } }
    }
}
__device__ __forceinline__ void index_unit(DSA_LAS unsigned char* lds, const bf16_t* __restrict__ P, const bf16_t* __restrict__ KIT, const float* __restrict__ WI, bf16_t* __restrict__ IDXG, int b, int t0, int nb, int nt0, IdxQ& Q, int wid, int lane) {
    const long rowbase = (long)b * SEQ;
    DSA_LAS float* SC = (DSA_LAS float*)(lds + LDS_SC);
    DSA_LAS unsigned short* myidx = (DSA_LAS unsigned short*)(lds + LDS_IDX) + wid * TOPK;
    {
        const int r = lane & 31, h8 = lane >> 5;
        const int ntile = (t0 + 8 + 31) >> 5;
        const bf16_t* kbase = KIT + (size_t)b * SLAB_EL + lane * 8;
        bf16x8 Bw[IDX_D][4];
#pragma unroll
        for (int i = 0; i < IDX_D; ++i) { int kt = wid + 8 * i; kt = kt < ntile ? kt : ntile - 1;
#pragma unroll
            for (int s = 0; s < 4; ++s) Bw[i][s] = *(const bf16x8*)(kbase + (size_t)(kt * 4 + s) * 512); }
        for (int base = 0; wid + 8 * base < ntile; base += IDX_D) {
#pragma unroll
            for (int i = 0; i < IDX_D; ++i) { const int kt = wid + 8 * (base + i);
                if (kt < ntile) {
                    f32x16 acc[2];
#pragma unroll
                    for (int rt = 0; rt < 2; ++rt) { acc[rt] = (f32x16){0.f, 0.f, 0.f, 0.f, 0.f, 0.f, 0.f, 0.f, 0.f, 0.f, 0.f, 0.f, 0.f, 0.f, 0.f, 0.f};
#pragma unroll
                        for (int s = 0; s < 4; ++s) acc[rt] = __builtin_amdgcn_mfma_f32_32x32x16_bf16(Q.A[rt][s], Bw[i][s], acc[rt], 0, 0, 0); }
                    { int ktn = kt + 8 * IDX_D; ktn = ktn < ntile ? ktn : ntile - 1;
#pragma unroll
                      for (int s = 0; s < 4; ++s) Bw[i][s] = *(const bf16x8*)(kbase + (size_t)(ktn * 4 + s) * 512); }
#pragma unroll
                    for (int rt = 0; rt < 2; ++rt) { float s0 = 0.f, s1 = 0.f;
#pragma unroll
                        for (int e = 0; e < 8; ++e) { s0 += Q.w[rt][e] * relu1(acc[rt][e]); s1 += Q.w[rt][8 + e] * relu1(acc[rt][8 + e]); }
                        SC[(4 * rt + 2 * h8 + 0) * SC_STRIDE + 32 * kt + r] = s0;
                        SC[(4 * rt + 2 * h8 + 1) * SC_STRIDE + 32 * kt + r] = s1; }
                } }
        }
        index_load_q(Q, P, WI, (long)nb * SEQ, nt0, lane);
    }
    __syncthreads();
    const int t = t0 + wid, n = t + 1;
    const float NINF = -__builtin_inff(), PINF = __builtin_inff();
    int lk = lane; asm volatile("" : "+v"(lk));
    f32x2 vp[32];
#define V(j) vp[(j) >> 1][(j) & 1]
#pragma unroll
    for (int j = 0; j < 32; ++j) vp[j] = (f32x2){NINF, NINF};
    if (n > TOPK) {
        const DSA_LAS float* row = SC + wid * SC_STRIDE;
#pragma unroll
        for (int g = 0; g < 8; ++g) if (512 * g < n) {
#pragma unroll
            for (int j = 8 * g; j < 8 * g + 8; ++j) { const int key = 64 * j + lk; const float x = row[key]; V(j) = (key < n) ? x : NINF; } }
    }
    asm volatile("s_waitcnt lgkmcnt(0)" ::: "memory");
    __syncthreads();
    bf16_t* gl = IDXG + (size_t)b * SLAB_EL + (size_t)t * TOPK;
    if (n <= TOPK) {
        u32x2 o; o.x = (unsigned)(4 * lane) | ((unsigned)(4 * lane + 1) << 16); o.y = (unsigned)(4 * lane + 2) | ((unsigned)(4 * lane + 3) << 16);
        *(u32x2*)(gl + 4 * lane) = o;
    } else {
        float mx = NINF, nmn = NINF;
#pragma unroll
        for (int j = 0; j < 64; ++j) { mx = __builtin_fmaxf(mx, V(j)); nmn = __builtin_fmaxf(nmn, (V(j) == NINF) ? NINF : -V(j)); }
        mx = dpp_max_all(mx); const float mn = -dpp_max_all(nmn);
        DSA_LAS unsigned short* dummy = (DSA_LAS unsigned short*)(lds + LDS_DUMMY) + wid * 64 + lane;
        const int ng = (n + 511) >> 9;
#define DSA_GROUPS(BODY) switch (ng) { default: BODY(7) case 7: BODY(6) case 6: BODY(5) case 5: BODY(4) case 4: BODY(3) case 3: BODY(2) case 2: BODY(1) case 1: BODY(0) }
#define DSA_EMIT_CNT(g_) { _Pragma("unroll") for (int j_ = 8 * (g_); j_ < 8 * (g_) + 8; ++j_) cl_ += (DSA_PRED(V(j_), T)) ? 1 : 0; }
#define DSA_EMIT_WR(g_) { _Pragma("unroll") for (int j_ = 8 * (g_); j_ < 8 * (g_) + 8; ++j_) { const bool sel_ = DSA_PRED(V(j_), Tw_); \
                DSA_LAS unsigned short* dst_ = sel_ ? (myidx + (pos_ & (TOPK - 1))) : dummy; *dst_ = (unsigned short)(64 * j_ + lk); pos_ += sel_ ? 1 : 0; } }
#define DSA_EMIT(OKV) do { int cl_ = 0; DSA_GROUPS(DSA_EMIT_CNT) \
            int pos_ = dpp_scan_add(cl_); OKV = (__builtin_amdgcn_readlane(pos_, 63) == TOPK); pos_ -= cl_; asm volatile("" : "+v"(pos_)); \
            if (OKV) { float Tw_ = T; asm volatile("" : "+v"(Tw_));     \
                DSA_GROUPS(DSA_EMIT_WR) } } while (0)
#define DSA_CMP8(OP, g_) { unsigned long long m0_, m1_, m2_, m3_, m4_, m5_, m6_, m7_; \
            asm volatile("v_cmp_" OP "_f32_e64 %0, %8, %16\n\tv_cmp_" OP "_f32_e64 %1, %9, %16\n\tv_cmp_" OP "_f32_e64 %2, %10, %16\n\tv_cmp_" OP "_f32_e64 %3, %11, %16\n\t" \
                         "v_cmp_" OP "_f32_e64 %4, %12, %16\n\tv_cmp_" OP "_f32_e64 %5, %13, %16\n\tv_cmp_" OP "_f32_e64 %6, %14, %16\n\tv_cmp_" OP "_f32_e64 %7, %15, %16" \
                         : "=s"(m0_), "=s"(m1_), "=s"(m2_), "=s"(m3_), "=s"(m4_), "=s"(m5_), "=s"(m6_), "=s"(m7_) \
                         : "v"(V(8 * (g_))), "v"(V(8 * (g_) + 1)), "v"(V(8 * (g_) + 2)), "v"(V(8 * (g_) + 3)), "v"(V(8 * (g_) + 4)), "v"(V(8 * (g_) + 5)), "v"(V(8 * (g_) + 6)), "v"(V(8 * (g_) + 7)), "v"(xx_)); \
            c_ += (__builtin_popcountll(m0_) + __builtin_popcountll(m1_)) + (__builtin_popcountll(m2_) + __builtin_popcountll(m3_)) + (__builtin_popcountll(m4_) + __builtin_popcountll(m5_)) + (__builtin_popcountll(m6_) + __builtin_popcountll(m7_)); }
#define DSA_CGE_GRP(g_) DSA_CMP8("ge", g_)
#define DSA_CGT_GRP(g_) DSA_CMP8("gt", g_)
#define DSA_COUNT_GE(X, C) do { int c_ = 0; const float xx_ = (X); DSA_GROUPS(DSA_CGE_GRP) C = c_; } while (0)
#define DSA_COUNT_GT(X, C) do { int c_ = 0; const float xx_ = (X); DSA_GROUPS(DSA_CGT_GRP) C = c_; } while (0)
        float lo, hi, T = 0.f; int c_lo, c_hi, c_gt = 0; bool tie = false, found = false;
        { int c0, cp; DSA_COUNT_GE(0.0f, c0); DSA_COUNT_GT(0.0f, cp);
          if (cp < TOPK && c0 >= TOPK) { T = 0.f; tie = true; c_gt = cp; found = true; }
          else if (cp >= TOPK) { lo = 0.f; c_lo = c0; hi = mx; c_hi = 1; }
          else { lo = mn; c_lo = n; hi = 0.f; c_hi = c0 > 0 ? c0 : 1; } }
        if (!found) {
            for (int it = 0;; ++it) {
                float x;
                if ((it % 3) == 2) x = 0.5f * lo + 0.5f * hi;
                else { const float llo = __builtin_amdgcn_logf((float)c_lo), lhi = __builtin_amdgcn_logf((float)c_hi); float tt = (llo - 8.0f) / (llo - lhi + 1e-6f); tt = __builtin_fminf(__builtin_fmaxf(tt, 0.03f), 0.97f); x = lo + (hi - lo) * tt; }
                if (!(x > lo && x < hi)) { x = 0.5f * lo + 0.5f * hi; if (!(x > lo && x < hi)) { T = lo; tie = true; DSA_COUNT_GT(T, c_gt); break; } }
                int c; DSA_COUNT_GE(x, c);
                if (c == TOPK) { T = x; tie = false; break; }
                if (c > TOPK) { lo = x; c_lo = c; } else { hi = x; c_hi = c > 0 ? c : 1; }
            }
        }
#undef DSA_COUNT_GT
#undef DSA_CGT_GRP
#undef DSA_CMP8
#undef DSA_COUNT_GE
#undef DSA_CGE_GRP
        bool done = false;
        if (!tie) {
#define DSA_PRED(val, thr) ((val) >= (thr))
            DSA_EMIT(done);
#undef DSA_PRED
        }
        if (!done) {
            int base = 0, eqbase = 0; const int need_eq = TOPK - c_gt;
#pragma unroll
            for (int j = 0; j < 64; ++j) {
                const bool gt = V(j) > T, eq = V(j) == T; const unsigned long long me = __builtin_amdgcn_ballot_w64(eq); const int rk = eqbase + mbcnt64(me); eqbase += __builtin_popcountll(me);
                const bool sel = gt || (eq && rk < need_eq);
                const unsigned long long m = __builtin_amdgcn_ballot_w64(sel); const int pos = base + mbcnt64(m);
                if (sel && pos < TOPK) myidx[pos] = (unsigned short)(64 * j + lk);
                base += __builtin_popcountll(m);
            }
        }
#undef DSA_EMIT
#undef DSA_EMIT_CNT
#undef DSA_EMIT_WR
#undef DSA_GROUPS
        asm volatile("s_waitcnt lgkmcnt(0)" ::: "memory");
        const u32x2 o = *(const DSA_LAS u32x2*)(myidx + 4 * lane);
        *(u32x2*)(gl + 4 * lane) = o;
    }
#undef V
}

__device__ __forceinline__ void index_phase(DSA_LAS unsigned char* lds, const bf16_t* P, const bf16_t* KIT, const float* WI, bf16_t* IDXG, int vcu, int G, int wid, int lane) {
#define DSA_UNIT_OF(I, B_, U_, OK_) do { if (G == 256) { OK_ = (I) < 16; const int k_ = 15 - ((I) < 16 ? (I) : 15), r_ = vcu & 31; B_ = vcu >> 5; U_ = 32 * k_ + ((k_ & 1) ? (31 - r_) : r_); } \
        else { const int ug_ = vcu + (I) * G; OK_ = ug_ < 8 * 512; const int uc_ = OK_ ? ug_ : vcu; B_ = uc_ >> 9; U_ = uc_ & 511; } } while (0)
    int b, u; bool ok; DSA_UNIT_OF(0, b, u, ok);
    IdxQ Q;
    if (ok) index_load_q(Q, P, WI, (long)b * SEQ, 8 * u, lane);
    for (int i = 0; ok; ++i) {
        int nb, nu; bool nok; DSA_UNIT_OF(i + 1, nb, nu, nok);
        if (!nok) { nb = b; nu = u; }
        index_unit(lds, P, KIT, WI, IDXG, b, 8 * u, nb, 8 * nu, Q, wid, lane);
        b = nb; u = nu; ok = nok;
    }
#undef DSA_UNIT_OF
    asm volatile("s_waitcnt vmcnt(0)" ::: "memory");
    __syncthreads();
}

constexpr int LDS_LI2 = 136704, LDS_KT = 140800;
constexpr int LDS_LI2_UNUSED_ = 0;
__device__ __forceinline__ void glds16s(const void* sbase, unsigned voff, unsigned lds_dst) { unsigned keep;
    asm volatile("s_mov_b32 %0, m0\n\ts_mov_b32 m0, %2\n\ts_nop 0\n\tglobal_load_lds_dwordx4 %1, %3\n\ts_mov_b32 m0, %0" : "=&s"(keep) : "v"(voff), "s"(lds_dst), "s"(sbase) : "memory"); }
__device__ __forceinline__ void attn_phase(DSA_LAS unsigned char* lds, const bf16_t* __restrict__ P, const bf16_t* __restrict__ KV, const bf16_t* __restrict__ IDXG, bf16_t* __restrict__ O, int vcu, int G, int wid, int lane_in) {
    DSA_LAS unsigned char* vimg = lds + LDS_SC + wid * 16384;
    DSA_LAS unsigned short* liA = (DSA_LAS unsigned short*)(lds + LDS_IDX) + wid * TOPK;
    DSA_LAS unsigned short* liB = (DSA_LAS unsigned short*)(lds + LDS_LI2) + wid * TOPK;
    const unsigned vaddr = (unsigned)(unsigned long long)vimg;
    const int nrows = 8 * SEQ;
    (void)nrows;
    const int nq = (G == 256) ? 16 : ((8 * 512 - vcu + G - 1) / G);
#define DSA_ROWI(I) ((G == 256) ? ((vcu >> 5) * SEQ + 8 * (32 * (15 - (I)) + (((15 - (I)) & 1) ? (31 - (vcu & 31)) : (vcu & 31))) + wid) : ((((vcu + (I) * G) >> 9) * SEQ) + 8 * ((vcu + (I) * G) & 511) + wid))
    const int row0 = DSA_ROWI(0);
    if (nq <= 0) return;
    int lane = lane_in;
#define DSA_LOFF(R_) ((size_t)((R_) >> 12) * SLAB_EL + (size_t)((R_) & (SEQ - 1)) * TOPK)
#define DSA_KGATHER(LI, ROW) do { const char* kvb_ = (const char*)(KV + (size_t)((ROW) >> 12) * SLAB_EL); DSA_LAS const unsigned short* lik_ = (LI) + (lane >> 3); const unsigned kc_ = (unsigned)((lane & 7) * 16); \
        _Pragma("unroll") for (int kt = 0; kt < 16; ++kt) { K0[kt] = *(const bf16x8*)(kvb_ + ((unsigned)lik_[16 * kt] * 256u + kc_)); K1[kt] = *(const bf16x8*)(kvb_ + ((unsigned)lik_[16 * kt + 8] * 256u + kc_)); } } while (0)
#define DSA_VCHUNK(LI, ROW, C, BOFF) do { const char* kvb_ = (const char*)(KV + (size_t)((ROW) >> 12) * SLAB_EL); DSA_LAS const unsigned short* liv_ = (LI) + (lane >> 3); \
        _Pragma("unroll") for (int i_ = 0; i_ < 8; ++i_) glds16s(kvb_, (unsigned)liv_[64 * (C) + 8 * i_] * 256u + vsw, (unsigned)__builtin_amdgcn_readfirstlane(vaddr + (BOFF) + i_ * 1024)); } while (0)
#define DSA_PV(C, BOFF) do { _Pragma("unroll") for (int k2_ = 0; k2_ < 2; ++k2_) { const bf16x8 PF_ = __builtin_bit_cast(bf16x8, pw[2 * (C) + k2_]); \
        _Pragma("unroll") for (int nd = 0; nd < 4; ++nd) { const s16x4 vlo_ = trrd(vb[nd] + (BOFF) + k2_ * 4096); const s16x4 vhi_ = trrd(vb[nd] + (BOFF) + k2_ * 4096 + 2048); \
            const bf16x8 VF_ = (bf16x8){vlo_[0], vlo_[1], vlo_[2], vlo_[3], vhi_[0], vhi_[1], vhi_[2], vhi_[3]}; o[nd] = __builtin_amdgcn_mfma_f32_16x16x32_bf16(PF_, VF_, o[nd], 0, 0, 0); } } } while (0)
    bf16x8 K0[16], K1[16];
    u32x2 nl;
    { const int c16 = lane & 15, g4 = lane >> 4; const unsigned vsw = 128u + (unsigned)(((lane & 7) ^ (((lane >> 4) & 3) << 1)) * 16);
      *(DSA_LAS u32x2*)(liA + 4 * lane) = *(const u32x2*)(IDXG + DSA_LOFF(row0) + 4 * lane);
      asm volatile("s_waitcnt vmcnt(0) lgkmcnt(0)" ::: "memory");
      DSA_VCHUNK(liA, row0, 0, 0); DSA_VCHUNK(liA, row0, 1, 8192);
      DSA_KGATHER(liA, row0);
      nl = *(const u32x2*)(IDXG + DSA_LOFF(nq > 1 ? DSA_ROWI(1) : row0) + 4 * lane); }
    for (int i = 0; i < nq; ++i) {
        const int row = DSA_ROWI(i); const bool has_next = (i + 1 < nq); const int nrow = has_next ? DSA_ROWI(i + 1) : row;
        DSA_LAS unsigned short* li = (i & 1) ? liB : liA; DSA_LAS unsigned short* lin = (i & 1) ? liA : liB;
        { int lq_ = lane; asm volatile("" : "+v"(lq_)); lane = lq_; }
        const int c16 = lane & 15, g4 = lane >> 4;
        const unsigned vsw = 128u + (unsigned)(((lane & 7) ^ (((lane >> 4) & 3) << 1)) * 16);
        const int t = row & (SEQ - 1); const int cntq = (t + 1 < TOPK) ? t + 1 : TOPK;
        *(DSA_LAS u32x2*)(lin + 4 * lane) = nl;
        { const int n2 = (i + 2 < nq) ? DSA_ROWI(i + 2) : row; nl = *(const u32x2*)(IDXG + DSA_LOFF(n2) + 4 * lane); }
        const char* qb = (const char*)(P + (size_t)row * PA + QOFF); const unsigned qoff = (unsigned)(c16 * 128 + g4 * 16);
        const bf16x8 Q0 = *(const bf16x8*)(qb + qoff), Q1 = *(const bf16x8*)(qb + qoff + 64);
        f32x4 st[16];
        { DSA_LAS unsigned char* ksc = lds + LDS_KT + wid * 2048;
          const int wr_ = (lane >> 3) * 128 + (((lane & 7) ^ ((lane >> 4) & 7)) * 16);
          const int rd_ = c16 * 128 + ((g4 ^ ((c16 >> 1) & 7)) * 16), rd1_ = c16 * 128 + (((4 + g4) ^ ((c16 >> 1) & 7)) * 16);
          *(DSA_LAS bf16x8*)(ksc + wr_) = K0[0]; *(DSA_LAS bf16x8*)(ksc + 1024 + (wr_ ^ 64)) = K1[0];
          bf16x8 A0 = *(const DSA_LAS bf16x8*)(ksc + rd_), A1 = *(const DSA_LAS bf16x8*)(ksc + rd1_);
#pragma unroll
          for (int kt = 0; kt < 16; ++kt) {
              bf16x8 B0 = A0, B1 = A1;
              if (kt + 1 < 16) { *(DSA_LAS bf16x8*)(ksc + wr_) = K0[kt + 1]; *(DSA_LAS bf16x8*)(ksc + 1024 + (wr_ ^ 64)) = K1[kt + 1];
                                 B0 = *(const DSA_LAS bf16x8*)(ksc + rd_); B1 = *(const DSA_LAS bf16x8*)(ksc + rd1_); }
              __builtin_amdgcn_sched_barrier(0);
              f32x4 a = {0.f, 0.f, 0.f, 0.f};
              a = __builtin_amdgcn_mfma_f32_16x16x32_bf16(A0, Q0, a, 0, 0, 0);
              a = __builtin_amdgcn_mfma_f32_16x16x32_bf16(A1, Q1, a, 0, 0, 0);
              st[kt] = a; A0 = B0; A1 = B1;
              __builtin_amdgcn_sched_barrier(0); } }
        if (cntq < TOPK) { int g4m = g4; asm volatile("" : "+v"(g4m));
#pragma unroll
            for (int kt = 0; kt < 16; ++kt)
#pragma unroll
                for (int r = 0; r < 4; ++r) if (16 * kt + 4 * g4m + r >= cntq) st[kt][r] = -__builtin_inff(); }
        float m = -__builtin_inff();
#pragma unroll
        for (int kt = 0; kt < 16; ++kt) m = __builtin_fmaxf(m, __builtin_fmaxf(__builtin_fmaxf(st[kt][0], st[kt][1]), __builtin_fmaxf(st[kt][2], st[kt][3])));
        m = __builtin_fmaxf(m, __shfl_xor(m, 16)); m = __builtin_fmaxf(m, __shfl_xor(m, 32));
        float lsum = 0.f;
#pragma unroll
        for (int kt = 0; kt < 16; ++kt) { st[kt] = st[kt] - m;
#pragma unroll
            for (int r = 0; r < 4; ++r) { st[kt][r] = __builtin_amdgcn_exp2f(st[kt][r]); lsum += st[kt][r]; } }
        lsum += __shfl_xor(lsum, 16); lsum += __shfl_xor(lsum, 32);
        u32x4 pw[8];
#pragma unroll
        for (int ks = 0; ks < 8; ++ks) { pw[ks].x = cvtpk(st[2 * ks][0], st[2 * ks][1]); pw[ks].y = cvtpk(st[2 * ks][2], st[2 * ks][3]); pw[ks].z = cvtpk(st[2 * ks + 1][0], st[2 * ks + 1][1]); pw[ks].w = cvtpk(st[2 * ks + 1][2], st[2 * ks + 1][3]); }
        f32x4 o[4];
#pragma unroll
        for (int nd = 0; nd < 4; ++nd) o[nd] = (f32x4){0.f, 0.f, 0.f, 0.f};
        const int q_ = c16 >> 2, p_ = lane & 3, F2 = (2 * (g4 & 1) + (q_ >> 1)) << 1;
        DSA_LAS const unsigned char* vb[4];
#pragma unroll
        for (int nd = 0; nd < 4; ++nd) vb[nd] = vimg + (4 * g4 + q_) * 128 + (((2 * nd) ^ F2) + (p_ >> 1)) * 16 + (p_ & 1) * 8;
        asm volatile("s_waitcnt vmcnt(8)" ::: "memory");
        DSA_PV(0, 0);
        asm volatile("s_waitcnt lgkmcnt(0)" ::: "memory"); DSA_VCHUNK(li, row, 2, 0);
        asm volatile("s_waitcnt vmcnt(8)" ::: "memory");
        DSA_PV(1, 8192);
        asm volatile("s_waitcnt lgkmcnt(0)" ::: "memory"); DSA_VCHUNK(li, row, 3, 8192);
        if (has_next) { DSA_KGATHER(lin, nrow); asm volatile("s_waitcnt vmcnt(40)" ::: "memory"); }
        else asm volatile("s_waitcnt vmcnt(8)" ::: "memory");
        DSA_PV(2, 0);
        asm volatile("s_waitcnt lgkmcnt(0)" ::: "memory");
        if (has_next) { DSA_VCHUNK(lin, nrow, 0, 0); asm volatile("s_waitcnt vmcnt(40)" ::: "memory"); }
        else asm volatile("s_waitcnt vmcnt(0)" ::: "memory");
        DSA_PV(3, 8192);
        asm volatile("s_waitcnt lgkmcnt(0)" ::: "memory");
        if (has_next) DSA_VCHUNK(lin, nrow, 1, 8192);
        const float linv = 1.0f / lsum;
        bf16_t* op = O + (size_t)row * 1024 + (4 * g4) * 64 + c16;
#pragma unroll
        for (int r = 0; r < 4; ++r) { const float lv = __shfl(linv, 4 * g4 + r);
#pragma unroll
            for (int nd = 0; nd < 4; ++nd) { const unsigned pk = cvtpk(o[nd][r] * lv, 0.f); op[r * 64 + 16 * nd] = (bf16_t)(pk & 0xffffu); } }
    }
#undef DSA_KGATHER
#undef DSA_ROWI
#undef DSA_LOFF
#undef DSA_VCHUNK
#undef DSA_PV
}
#undef DSA_LAS
}

constexpr int NWAVES = 8;
constexpr int NB = 8, SEQ = 4096, D = 1024, FF = 2752, FFP = 2816, NGU = 5632, DEPTH = 4;
constexpr int M = NB * SEQ;
constexpr int A_IN = 1736, A_INP = 1792, B_IN = 3072;
constexpr float EPS = 1e-6f;
constexpr float QSCALE = 0.125f * 1.4426950408889634f;
constexpr float WISCALE = 0.04419417382415922f;
constexpr size_t MiB = 1u << 20;
constexpr size_t WS_CTL = 0, CTL_ZERO_BYTES = 1 * MiB;
constexpr size_t WS_MOD = 2 * MiB;
constexpr size_t WS_ROPE = 4 * MiB;
constexpr size_t WS_WI = 6 * MiB;
constexpr size_t WS_W = 8 * MiB;
constexpr size_t W_FFN_STRIDE = 17301504, W_D_OFF = 11534336;
constexpr size_t W_DSA = WS_W + 8 * W_FFN_STRIDE, W_DSA_STRIDE = 5767168, W_DSA_OUT_OFF = 3670016;
constexpr size_t W_DIFF = W_DSA + 2 * W_DSA_STRIDE, W_DIFF_STRIDE = 8 * MiB, W_DIFF_OUT_OFF = 6 * MiB;
constexpr size_t WS_H = 168 * MiB;
constexpr size_t WS_Y = 232 * MiB;
constexpr size_t WS_BIG = 296 * MiB;
constexpr size_t WS_XB = 488 * MiB;
constexpr size_t WS_END = 552 * MiB;
constexpr size_t WS_KIT = WS_Y, WS_KV = WS_Y + 1 * MiB, WS_IDXL = WS_Y + 2 * MiB;
constexpr int BIG_LD = 3072;
static_assert(BIG_LD == B_IN && BIG_LD >= FFP && BIG_LD >= A_INP && BIG_LD == dsa::PA && pg8::SLAB_EL * 2 * NB == 64 * MiB, "batch-private layouts");
static_assert(W_DIFF + 2 * W_DIFF_STRIDE <= WS_H && WS_Y == WS_H + 64 * MiB && WS_BIG == WS_Y + 64 * MiB && WS_BIG + (size_t)M * B_IN * 2 <= WS_XB && WS_XB + (size_t)M * D * 2 <= WS_END, "d_ws map");
constexpr int CW_BAR = 4096;
constexpr int RING_OFF = 0, RING_BYTES = 131072;
constexpr int IDX_OFF = RING_BYTES;
constexpr int LDSCTL_OFF = RING_BYTES + 4096, MISC_OFF = LDSCTL_OFF + 320;
constexpr int LDS_BYTES = 157184;
static_assert(MISC_OFF + 128 <= dsa::LDS_DUMMY && dsa::LDS_DUMMY + 1024 <= dsa::LDS_LI2 && dsa::LDS_LI2 + 4096 <= dsa::LDS_KT && dsa::LDS_KT + 8 * 2048 <= LDS_BYTES && dsa::LDS_IDX == IDX_OFF, "LDS map");

__device__ __forceinline__ float wave_sum(float v) {
#define WS_STEP(ctrl, rm) v += __builtin_bit_cast(float, __builtin_amdgcn_update_dpp(0, __builtin_bit_cast(int, v), ctrl, rm, 0xf, false))
    WS_STEP(0x111, 0xf); WS_STEP(0x112, 0xf); WS_STEP(0x114, 0xf); WS_STEP(0x118, 0xf); WS_STEP(0x142, 0xa); WS_STEP(0x143, 0xc);
#undef WS_STEP
    return __builtin_bit_cast(float, __builtin_amdgcn_readlane(__builtin_bit_cast(int, v), 63));
}
__device__ __forceinline__ int rope_perm16(int p) { return (p < 8) ? ((p & 1) ? 8 + (p >> 1) : (p >> 1)) : ((p & 1) ? 12 + ((p - 8) >> 1) : 4 + ((p - 8) >> 1)); }
__device__ __forceinline__ void tr_item(const float* W, int ldw, int Ksrc, int ncols, bf16* WT, int ldt, int k0, int d0, int col0, bool perm, LAS float* scr, int lane) {
    const int c4 = lane & 7, kr = lane >> 3, colb = col0 + 4 * c4;
    const bool cok = (col0 >= 0) && (colb < ncols);
    f32x4 tv[8];
#pragma unroll
    for (int i = 0; i < 8; ++i) { const int k = k0 + 8 * i + kr; tv[i] = (cok && k < Ksrc) ? *(const f32x4*)(W + (size_t)k * ldw + colb) : (f32x4){0.f, 0.f, 0.f, 0.f}; }
#pragma unroll
    for (int i = 0; i < 8; ++i) { LAS float* p = scr + (8 * i + kr) * 33 + 4 * c4; p[0] = tv[i].x; p[1] = tv[i].y; p[2] = tv[i].z; p[3] = tv[i].w; }
    LDS_WAIT(); asm volatile("" ::: "memory");
    const int c = lane & 7;
#pragma unroll
    for (int j = 0; j < 4; ++j) { const int n = (lane >> 3) + 8 * j; const int pn = (perm && n < 16) ? rope_perm16(n) : n;
        const LAS float* s = scr + (8 * c) * 33 + pn;
        v4u o; o.x = pk2(s[0 * 33], s[1 * 33]); o.y = pk2(s[2 * 33], s[3 * 33]); o.z = pk2(s[4 * 33], s[5 * 33]); o.w = pk2(s[6 * 33], s[7 * 33]);
        *(GAS v4u*)(WT + (size_t)(d0 + n) * ldt + k0 + 8 * c) = o; }
    LDS_WAIT(); asm volatile("" ::: "memory");
}

using pg8::pk4_fp8;
__device__ __forceinline__ void tr_item8(const float* W, int ldw, int Ksrc, int ncols, unsigned char* WT8, int ldt, int k0, int d0, int col0, float scale, LAS float* scr, int lane, bool perm = false) {
    const int c4 = lane & 7, kr = lane >> 3, colb = col0 + 4 * c4;
    const bool cok = (col0 >= 0) && (colb < ncols);
    f32x4 tv[8];
#pragma unroll
    for (int i = 0; i < 8; ++i) { const int k = k0 + 8 * i + kr; tv[i] = (cok && k < Ksrc) ? *(const f32x4*)(W + (size_t)k * ldw + colb) : (f32x4){0.f, 0.f, 0.f, 0.f}; }
#pragma unroll
    for (int i = 0; i < 8; ++i) { LAS float* p = scr + (8 * i + kr) * 33 + 4 * c4; p[0] = tv[i].x * scale; p[1] = tv[i].y * scale; p[2] = tv[i].z * scale; p[3] = tv[i].w * scale; }
    LDS_WAIT(); asm volatile("" ::: "memory");
    const int c = lane & 7;
#pragma unroll
    for (int j = 0; j < 4; ++j) { const int n = (lane >> 3) + 8 * j; const int pn = (perm && n < 16) ? rope_perm16(n) : n;
        const LAS float* s = scr + (8 * c) * 33 + pn;
        typedef unsigned v2u_ __attribute__((ext_vector_type(2)));
        v2u_ o; o.x = pk4_fp8(s[0 * 33], s[1 * 33], s[2 * 33], s[3 * 33]); o.y = pk4_fp8(s[4 * 33], s[5 * 33], s[6 * 33], s[7 * 33]);
        *(GAS v2u_*)(WT8 + (size_t)(d0 + n) * ldt + k0 + 8 * c) = o; }
    LDS_WAIT(); asm volatile("" ::: "memory");
}

struct Args { const float* in[16]; float* out; unsigned char* ws; };

typedef const __attribute__((address_space(4))) Args* kargs_t0;
__device__ __forceinline__ void p0_prologue(kargs_t0 ap, LAS unsigned char* lds, int tid, int lane, int wave, int vcu, int G) {
    unsigned char* ws = ap->ws;
    if (vcu < 144) {
        LAS float* cond = (LAS float*)lds;
        LAS float* red = (LAS float*)(lds + 32768);
        const float* cin = ap->in[1];
        for (int i = tid; i < 8 * 1024; i += NWAVES * 64) { const float x = cin[i]; cond[i] = x / (1.0f + __expf(-x)); }
        __syncthreads();
        const int l = vcu / 36, n0 = (vcu % 36) * 256;
        const float* Wl = ap->in[3] + (size_t)l * 1024 * 9216 + n0 + 4 * lane;
        f32x4 acc[8];
#pragma unroll
        for (int b = 0; b < 8; ++b) acc[b] = (f32x4){0.f, 0.f, 0.f, 0.f};
        for (int kb = 0; kb < 128; kb += 8) { f32x4 wv[8];
#pragma unroll
            for (int u = 0; u < 8; ++u) wv[u] = *(const f32x4*)(Wl + (size_t)(128 * wave + kb + u) * 9216);
#pragma unroll
            for (int u = 0; u < 8; ++u) { const int k = 128 * wave + kb + u;
#pragma unroll
                for (int b = 0; b < 8; ++b) acc[b] += wv[u] * cond[b * 1024 + k]; } }
#pragma unroll
        for (int b = 0; b < 8; ++b) *(LAS f32x4*)(red + (wave * 8 + b) * 256 + 4 * lane) = acc[b];
        __syncthreads();
        { const int o = tid * 4, b = o >> 8, col = o & 255; f32x4 s = *(const f32x4*)(ap->in[4] + (size_t)l * 9216 + n0 + col);
#pragma unroll
          for (int w = 0; w < 8; ++w) s += *(LAS f32x4*)(red + (w * 8 + b) * 256 + col);
          *(f32x4*)((float*)(ws + WS_MOD) + ((size_t)l * 8 + b) * 9216 + n0 + col) = s; }
        __syncthreads();
    }
    { const int* pos = (const int*)ap->in[2]; float* tab = (float*)(ws + WS_ROPE);
      for (int i = vcu * (NWAVES * 64) + tid; i < M * 8; i += G * NWAVES * 64) { const int row = i >> 3, j = i & 7;
          const float inv = (j == 0) ? 1.0f : (j == 1) ? 0.19392274474868576f : (j == 2) ? 0.03760603093086393f : (j == 3) ? 0.007292664737217109f : (j == 4) ? 0.001414213562373095f : (j == 5) ? 0.0002742481756762073f : (j == 6) ? 5.318295896944988e-05f : 1.031338537721246e-05f;
          const float ang = (float)pos[row] * inv;
          const double rev = (double)ang * 0.15915494309189535; const float fr = (float)(rev - __builtin_rint(rev));
          tab[(size_t)row * 16 + j] = __builtin_amdgcn_cosf(fr); tab[(size_t)row * 16 + 8 + j] = __builtin_amdgcn_sinf(fr); } }
    LAS float* scr = (LAS float*)(lds + wave * 16384);
    const int gw = vcu * NWAVES + wave, NGW = G * NWAVES;
    constexpr int I_GU = 16 * 176, I_D = 44 * 32, I_FFN = I_GU + I_D, I_AIN = 16 * 56, I_O = 16 * 32, I_DSA = I_AIN + I_O, I_BIN = 16 * 96, I_DIFF = I_BIN + I_O;
    constexpr int NITEMS = 8 * I_FFN + 2 * I_DSA + 2 * I_DIFF;
    const int nmw = (G > 144) ? (G - 144) * NWAVES : 0; const int X = (nmw * 16 < NITEMS) ? nmw * 16 : NITEMS;
    const int w1 = (vcu - 144) * NWAVES + wave; const int n1 = (vcu >= 144 && w1 < X) ? (X - w1 + nmw - 1) / nmw : 0;
    for (int k = 0;; ++k) {
        const int it = (k < n1) ? w1 + k * nmw : X + gw + (k - n1) * NGW; if (it >= NITEMS) break;
        int r = it;
        if (r < 8 * I_FFN) { const int f = r / I_FFN; r -= f * I_FFN;
            if (r < I_GU) { const int kb = r / 176, nb = r % 176, d0 = 32 * nb, p = d0 >> 8, w0 = d0 & 255; const bool up = w0 >= 128;
                const float* W = (up ? ap->in[8] : ap->in[7]) + (size_t)f * 1024 * FF;
                tr_item8(W, FF, 1024, FF, ws + WS_W + f * W_FFN_STRIDE, 1024, 64 * kb, d0, 128 * p + (w0 & 127), 64.0f, scr, lane); }
            else { r -= I_GU; const int kb = r / 32, nb = r % 32;
                tr_item8(ap->in[9] + (size_t)f * FF * 1024, 1024, FF, 1024, ws + WS_W + f * W_FFN_STRIDE + W_D_OFF, FFP, 64 * kb, 32 * nb, 32 * nb, 64.0f, scr, lane); }
            continue; }
        r -= 8 * I_FFN;
        if (r < 2 * I_DSA) { const int j = r / I_DSA; r -= j * I_DSA;
            if (r < I_AIN) { const int kb = r / 56, nb = r % 56, d0 = 32 * nb; const bool perm = (d0 < 1728) && !(d0 >= 1088 && d0 < 1152) && ((d0 & 63) == 0);
                tr_item(ap->in[10] + (size_t)j * 1024 * A_IN, A_IN, 1024, A_IN, (bf16*)(ws + W_DSA + j * W_DSA_STRIDE), 1024, 64 * kb, d0, d0, perm, scr, lane); }
            else { r -= I_AIN; const int kb = r / 32, nb = r % 32;
                tr_item(ap->in[11] + (size_t)j * 1024 * 1024, 1024, 1024, 1024, (bf16*)(ws + W_DSA + j * W_DSA_STRIDE + W_DSA_OUT_OFF), 1024, 64 * kb, 32 * nb, 32 * nb, false, scr, lane); }
            continue; }
        r -= 2 * I_DSA;
        { const int j = r / I_DIFF; r -= j * I_DIFF;
            if (r < I_BIN) { const int kb = r / 96, nb = r % 96, d0 = 32 * nb; const bool perm = (d0 < 2048) && ((d0 & 63) == 0);
                tr_item8(ap->in[12] + (size_t)j * 1024 * B_IN, B_IN, 1024, B_IN, ws + W_DIFF + j * W_DIFF_STRIDE, 1024, 64 * kb, d0, d0, 64.0f, scr, lane, perm); }
            else { r -= I_BIN; const int kb = r / 32, nb = r % 32;
                tr_item(ap->in[13] + (size_t)j * 1024 * 1024, 1024, 1024, 1024, (bf16*)(ws + W_DIFF + j * W_DIFF_STRIDE + W_DIFF_OUT_OFF), 1024, 64 * kb, 32 * nb, 32 * nb, false, scr, lane); }
        }
    }
}

template <bool HAS_Y, bool HAS_H, bool XIN32, bool XOUT32, bool H8 = false>
__device__ __forceinline__ void thin_phase(int gw, int NGW, int lane, const bf16* Y, const void* XIN, void* XOUT, bf16* HOUT,
                                           const float* gate, const float* pn, float coef, const float* pre, const float* sc, const float* sh, bool poison) {
#define TP_UNPK(q, lo, hi) do { lo = (f32x4){__builtin_bit_cast(float, q.x << 16), __builtin_bit_cast(float, q.x & 0xffff0000u), __builtin_bit_cast(float, q.y << 16), __builtin_bit_cast(float, q.y & 0xffff0000u)}; \
                                hi = (f32x4){__builtin_bit_cast(float, q.z << 16), __builtin_bit_cast(float, q.z & 0xffff0000u), __builtin_bit_cast(float, q.w << 16), __builtin_bit_cast(float, q.w & 0xffff0000u)}; } while (0)
#define TP_PK(lo, hi) (v4u){pk2(lo.x, lo.y), pk2(lo.z, lo.w), pk2(hi.x, hi.y), pk2(hi.z, hi.w)}
    for (int ch = gw; ch < M / 16; ch += NGW) {
        const int b = ch >> 8;
        f32x4 a1[4], a2[4], a3[4];
#pragma unroll
        for (int k = 0; k < 4; ++k) { const int col = 512 * (k >> 1) + 8 * lane + 4 * (k & 1);
            if (HAS_Y) a1[k] = *(const f32x4*)(gate + (size_t)b * 9216 + col) * *(const f32x4*)(pn + col) * coef;
            if (HAS_H) { a2[k] = *(const f32x4*)(pre + col) * (*(const f32x4*)(sc + (size_t)b * 9216 + col) + 1.0f); a3[k] = *(const f32x4*)(sh + (size_t)b * 9216 + col); } }
#pragma unroll 2
        for (int r = 0; r < 16; ++r) { const size_t row = (size_t)ch * 16 + r;
            f32x4 xv[4];
#pragma unroll
            for (int j = 0; j < 2; ++j) { const size_t off = row * D + 512 * j + 8 * lane;
                if (XIN32) { xv[2 * j] = *(const f32x4*)((const float*)XIN + off); xv[2 * j + 1] = *(const f32x4*)((const float*)XIN + off + 4); }
                else { const v4u q = __builtin_nontemporal_load((const v4u*)((const bf16*)XIN + off)); TP_UNPK(q, xv[2 * j], xv[2 * j + 1]); } }
            if (HAS_Y) { f32x4 yv[4]; float ss = 0.f;
#pragma unroll
                for (int j = 0; j < 2; ++j) { const v4u q = __builtin_nontemporal_load((const v4u*)(Y + row * D + 512 * j + 8 * lane)); TP_UNPK(q, yv[2 * j], yv[2 * j + 1]); }
#pragma unroll
                for (int k = 0; k < 4; ++k) ss += (yv[k].x * yv[k].x + yv[k].y * yv[k].y) + (yv[k].z * yv[k].z + yv[k].w * yv[k].w);
                const float rs = 1.0f / sqrtf(wave_sum(ss) * (1.0f / D) + EPS);
                const float qn = __builtin_nanf("");
#pragma unroll
                for (int k = 0; k < 4; ++k) xv[k] = xv[k] + a1[k] * yv[k] * rs;
#pragma unroll
                for (int j = 0; j < 2; ++j) { const size_t off = row * D + 512 * j + 8 * lane;
                    if (XOUT32) { *(f32x4*)((float*)XOUT + off) = poison ? (f32x4){qn, qn, qn, qn} : xv[2 * j]; *(f32x4*)((float*)XOUT + off + 4) = poison ? (f32x4){qn, qn, qn, qn} : xv[2 * j + 1]; }
                    else __builtin_nontemporal_store(TP_PK(xv[2 * j], xv[2 * j + 1]), (v4u*)((bf16*)XOUT + off)); } }
            else if (!XOUT32 && XOUT != nullptr) {
#pragma unroll
                for (int j = 0; j < 2; ++j) *(v4u*)((bf16*)XOUT + row * D + 512 * j + 8 * lane) = TP_PK(xv[2 * j], xv[2 * j + 1]); }
            if (HAS_H) { float s2 = 0.f;
#pragma unroll
                for (int k = 0; k < 4; ++k) s2 += (xv[k].x * xv[k].x + xv[k].y * xv[k].y) + (xv[k].z * xv[k].z + xv[k].w * xv[k].w);
                const float r2 = 1.0f / sqrtf(wave_sum(s2) * (1.0f / D) + EPS);
                f32x4 hv[4];
#pragma unroll
                for (int k = 0; k < 4; ++k) hv[k] = xv[k] * r2 * a2[k] + a3[k];
#pragma unroll
                for (int j = 0; j < 2; ++j) {
                    if (H8) { typedef unsigned v2u_ __attribute__((ext_vector_type(2))); const f32x4 p = hv[2 * j] * 16.0f, q2 = hv[2 * j + 1] * 16.0f;
                        v2u_ o; o.x = pk4_fp8(p.x, p.y, p.z, p.w); o.y = pk4_fp8(q2.x, q2.y, q2.z, q2.w); *(v2u_*)((unsigned char*)HOUT + row * (2 * D) + 512 * j + 8 * lane) = o; }
                    else *(v4u*)(HOUT + row * D + 512 * j + 8 * lane) = TP_PK(hv[2 * j], hv[2 * j + 1]); } }
        }
    }
#undef TP_UNPK
#undef TP_PK
}

typedef const __attribute__((address_space(4))) Args* kargs_t;
__device__ __forceinline__ kargs_t kargs_ptr() { kargs_t p = (kargs_t)__builtin_amdgcn_kernarg_segment_ptr(); asm volatile("" : "+s"(p)); return p; }
#define KARGS() const kargs_t A_ = kargs_ptr(); unsigned char* const ws = A_->ws; (void)ws
#define GRID_BAR() do { XcdBarrier bar_; { KARGS(); bar_.bar = (unsigned*)(ws + WS_CTL) + CW_BAR; } bar_.x = xb_xcc_id(); bar_.st = (volatile LAS unsigned*)(lds + MISC_OFF) + 8; if (lds_word_uniform((unsigned)(unsigned long long)(lds + MISC_OFF + 44)) != 0u) xcd_local_barrier(bar_); else xcd_barrier(bar_); } while (0)
#define VCU_G() int G_l = gridDim.x, bx_l = blockIdx.x; asm volatile("" : "+s"(bx_l)); { const unsigned m_ = lds_word_uniform((unsigned)(unsigned long long)(lds + MISC_OFF + 44)); int sel_; asm volatile("s_cmp_lg_u32 %1, 0\n\ts_cselect_b32 %0, %2, %3" : "=s"(sel_) : "s"(m_), "s"(m_ - 1u), "s"(bx_l) : "scc"); bx_l = sel_; } asm volatile("" : "+s"(G_l), "+s"(bx_l)); const int G = G_l; const int vcu = (G % 8 == 0) ? (bx_l % 8) * (G / 8) + bx_l / 8 : bx_l; (void)vcu
#define WAVE_IDS() int tid_l = threadIdx.x; asm volatile("" : "+v"(tid_l)); const int tid = tid_l, lane = tid & 63, wave = __builtin_amdgcn_readfirstlane(tid >> 6); (void)lane; (void)wave

__device__ __forceinline__ void ffn_block(LAS unsigned char* lds, int L, int S, bool first) {
    const int f_ = L * 2 + S;
    { KARGS(); VCU_G(); pg8::Gemm g{(const bf16*)(ws + WS_H), (const bf16*)(ws + WS_W + f_ * W_FFN_STRIDE), M, NGU, D / 2, D}; pg8::StaticOrder So; So.init(M, NGU, G, bx_l);
      pg8::EpiSwiGLU<true> E{(bf16*)(ws + WS_BIG), BIG_LD}; pg8::gemm_phase<pg8::EpiSwiGLU<true>, pg8::StaticOrder, true, true, true>(lds + RING_OFF, g, So, E); }
    GRID_BAR();
    { KARGS(); VCU_G(); pg8::Gemm g{(const bf16*)(ws + WS_BIG), (const bf16*)(ws + WS_W + f_ * W_FFN_STRIDE + W_D_OFF), M, D, FFP / 2, BIG_LD}; pg8::StaticOrder So; So.init(M, D, G, bx_l);
      pg8::EpiBf16<0> E{(bf16*)(ws + WS_Y), D}; pg8::gemm_phase<pg8::EpiBf16<0>, pg8::StaticOrder, true, true, true>(lds + RING_OFF, g, So, E); }
    GRID_BAR();
    { KARGS(); VCU_G(); WAVE_IDS(); const int gw = vcu * NWAVES + wave, NGW = G * NWAVES;
      const int k_ = S ? 2 : 0; const int ln_ = S ? L + 1 : L, kn_ = S ? 0 : 1;
      const float* mod = (const float*)(ws + WS_MOD); const float* pre_norm = A_->in[5]; const float* post_norm = A_->in[6];
      const bool poison_ = (__hip_atomic_load((gu32*)(ws + WS_CTL) + CW_BAR + XB_TMO, RLX_AGENT) != 0u);
      if (ln_ < DEPTH && (S || (L & 1))) thin_phase<true, true, false, false, true>(gw, NGW, lane, (const bf16*)(ws + WS_Y), ws + WS_XB, ws + WS_XB, (bf16*)(ws + WS_H), mod + (size_t)L * 73728 + (3 * k_ + 2) * 1024, post_norm + (L * 3 + k_) * 1024, 0.5f,
                            pre_norm + (ln_ * 3 + kn_) * 1024, mod + (size_t)ln_ * 73728 + (3 * kn_ + 1) * 1024, mod + (size_t)ln_ * 73728 + (3 * kn_) * 1024, poison_);
      else if (ln_ < DEPTH) thin_phase<true, true, false, false>(gw, NGW, lane, (const bf16*)(ws + WS_Y), ws + WS_XB, ws + WS_XB, (bf16*)(ws + WS_H), mod + (size_t)L * 73728 + (3 * k_ + 2) * 1024, post_norm + (L * 3 + k_) * 1024, 0.5f,
                            pre_norm + (ln_ * 3 + kn_) * 1024, mod + (size_t)ln_ * 73728 + (3 * kn_ + 1) * 1024, mod + (size_t)ln_ * 73728 + (3 * kn_) * 1024, poison_);
      else thin_phase<true, false, false, true>(gw, NGW, lane, (const bf16*)(ws + WS_Y), ws + WS_XB, A_->out, nullptr, mod + (size_t)L * 73728 + (3 * k_ + 2) * 1024, post_norm + (L * 3 + k_) * 1024, 0.5f, nullptr, nullptr, nullptr, poison_); }
    GRID_BAR();
}
__device__ __forceinline__ void mix_tail(LAS unsigned char* lds, int L, size_t a_off, size_t w_off) {
    { KARGS(); VCU_G(); pg8::Gemm g{(const bf16*)(ws + a_off), (const bf16*)(ws + w_off), M, D, D, D}; pg8::StaticOrder So; So.init(M, D, G, bx_l);
      pg8::EpiBf16<0> E{(bf16*)(ws + WS_Y), D}; pg8::gemm_phase<pg8::EpiBf16<0>, pg8::StaticOrder, true, true>(lds + RING_OFF, g, So, E); }
    GRID_BAR();
    { KARGS(); VCU_G(); WAVE_IDS(); const int gw = vcu * NWAVES + wave, NGW = G * NWAVES;
      const float* mod = (const float*)(ws + WS_MOD); const float* pre_norm = A_->in[5]; const float* post_norm = A_->in[6];
      thin_phase<true, true, false, false, true>(gw, NGW, lane, (const bf16*)(ws + WS_Y), ws + WS_XB, ws + WS_XB, (bf16*)(ws + WS_H), mod + (size_t)L * 73728 + 5 * 1024, post_norm + (L * 3 + 1) * 1024, 1.0f,
                             pre_norm + (L * 3 + 2) * 1024, mod + (size_t)L * 73728 + 7 * 1024, mod + (size_t)L * 73728 + 6 * 1024, false); }
    GRID_BAR();
}

__global__ void __launch_bounds__(NWAVES * 64, 2) hybrid_fwd(Args args) {
    extern __shared__ __attribute__((aligned(16))) unsigned char lds_raw[];
    LAS unsigned char* lds = (LAS unsigned char*)lds_raw;
    { WAVE_IDS(); for (int u = tid; u < (LDS_BYTES - LDSCTL_OFF) / 4; u += NWAVES * 64) ((LAS unsigned*)(lds + LDSCTL_OFF))[u] = 0u; }
    __syncthreads();
    { KARGS(); (void)xcd_barrier_post((unsigned*)(ws + WS_CTL) + CW_BAR, (volatile LAS unsigned*)(lds + MISC_OFF) + 8); }

    { KARGS(); VCU_G(); WAVE_IDS(); p0_prologue(A_, lds, tid, lane, wave, vcu, G); }
    GRID_BAR();
    { KARGS(); VCU_G(); WAVE_IDS(); const float* mod = (const float*)(ws + WS_MOD);
      thin_phase<false, true, true, false, true>(vcu * NWAVES + wave, G * NWAVES, lane, nullptr, A_->in[0], ws + WS_XB, (bf16*)(ws + WS_H), nullptr, nullptr, 0.f, A_->in[5], mod + 1024, mod, false); }
    GRID_BAR();

    for (int j = 0; j < 2; ++j) {
        const int la = 2 * j, lb = 2 * j + 1;
        ffn_block(lds, la, 0, j == 0);
        { KARGS(); VCU_G(); pg8::Gemm g{(const bf16*)(ws + WS_H), (const bf16*)(ws + W_DSA + j * W_DSA_STRIDE), M, A_INP, D, D}; pg8::StaticOrder So; So.init(M, A_INP, G, bx_l);
          pg8::EpiProj E{(bf16*)(ws + WS_BIG), BIG_LD, (const float*)(ws + WS_ROPE), 1728, 1088, 1152, 1024, QSCALE, (float*)(ws + WS_WI), 1728, WISCALE, (bf16*)(ws + WS_KIT), 1664, (bf16*)(ws + WS_KV), 1024};
          pg8::gemm_phase<pg8::EpiProj, pg8::StaticOrder, true, true>(lds + RING_OFF, g, So, E); }
        GRID_BAR();
        { KARGS(); VCU_G(); WAVE_IDS(); dsa::index_phase(lds, (const bf16*)(ws + WS_BIG), (const bf16*)(ws + WS_KIT), (const float*)(ws + WS_WI), (bf16*)(ws + WS_IDXL), vcu, G, wave, lane); }
        { KARGS(); VCU_G(); WAVE_IDS(); dsa::attn_phase(lds, (const bf16*)(ws + WS_BIG), (const bf16*)(ws + WS_KV), (const bf16*)(ws + WS_IDXL), (bf16*)(ws + WS_H), vcu, G, wave, lane); }
        GRID_BAR();
        mix_tail(lds, la, WS_H, W_DSA + j * W_DSA_STRIDE + W_DSA_OUT_OFF);
        ffn_block(lds, la, 1, false);
        ffn_block(lds, lb, 0, false);
        { KARGS(); VCU_G(); pg8::Gemm g{(const bf16*)(ws + WS_H), (const bf16*)(ws + W_DIFF + j * W_DIFF_STRIDE), M, B_IN, D / 2, D}; pg8::StaticOrder So; So.init(M, B_IN, G, bx_l);
          pg8::EpiProj E{(bf16*)(ws + WS_BIG), B_IN, (const float*)(ws + WS_ROPE), 2048, 0, 0, 1024, QSCALE, nullptr, -1, 0.f, nullptr, -1000, nullptr, -1000};
          pg8::gemm_phase<pg8::EpiProj, pg8::StaticOrder, true, true, true>(lds + RING_OFF, g, So, E); }
        GRID_BAR();
        { KARGS(); VCU_G(); const attn_body::bf16* P = (const attn_body::bf16*)(ws + WS_BIG);
          const attn_body::AttnTensors AT{P, P + 1024, P + 2048, (attn_body::bf16*)(ws + WS_Y), (attn_body::bf16*)(ws + WS_H), A_->in[14] + j * 256, A_->in[15] + j * 128, lb};
          attn_body::attn_phase<8>((char*)lds_raw + RING_OFF, AT, vcu, G); }
        GRID_BAR();
        mix_tail(lds, lb, WS_H, W_DIFF + j * W_DIFF_STRIDE + W_DIFF_OUT_OFF);
        ffn_block(lds, lb, 1, false);
    }
}

extern "C" void kernel_launch(void* const* d_in, const int* in_sizes, int n_in, void* d_out, int out_size, void* d_ws, size_t ws_size, hipStream_t stream) {
    static int grid = 0;
    if (grid == 0) {
        if (n_in != 16 || out_size != M * D || ws_size < WS_END) { fprintf(stderr, "kernel_launch: unexpected shapes (n_in %d, out %d, ws %zu); nothing launched\n", n_in, out_size, ws_size); grid = -1; return; }
        int dev = 0, cus = 0, per_cu = 0;
        if (hipGetDevice(&dev) != hipSuccess || hipDeviceGetAttribute(&cus, hipDeviceAttributeMultiprocessorCount, dev) != hipSuccess) { grid = -1; return; }
        if (hipFuncSetAttribute((const void*)hybrid_fwd, hipFuncAttributeMaxDynamicSharedMemorySize, LDS_BYTES) != hipSuccess) { fprintf(stderr, "kernel_launch: hipFuncSetAttribute failed\n"); grid = -1; return; }
        if (hipOccupancyMaxActiveBlocksPerMultiprocessor(&per_cu, (const void*)hybrid_fwd, NWAVES * 64, LDS_BYTES) != hipSuccess || per_cu < 1) { fprintf(stderr, "kernel_launch: occupancy query reports %d\n", per_cu); }
        (void)hipGetLastError();
        grid = cus;
    }
    if (grid < 0) return;
    if (hipMemsetAsync((char*)d_ws + WS_CTL, 0, CTL_ZERO_BYTES, stream) != hipSuccess) return;
    Args a{};
    for (int i = 0; i < 16; ++i) a.in[i] = (const float*)d_in[i];
    a.out = (float*)d_out; a.ws = (unsigned char*)d_ws;
    hipLaunchKernelGGL(hybrid_fwd, dim3(grid), dim3(NWAVES * 64), LDS_BYTES, stream, a);
}
```
